# Optimizing an MI355X kernel written in HIP

```python
import jax, jax.numpy as jnp
from jax import lax
import numpy as np

D_MODEL = 1024
BATCH = 8
SEQ = 4096
DEPTH = 4

N_MIXERS = 2
N_ATTN_LAYERS = (DEPTH + 1) // 2
N_SGU_LAYERS = DEPTH // 2

N_HEADS = 16
N_KV_HEADS = 4
HEAD_DIM = 64
Q_PER_KV = N_HEADS // N_KV_HEADS
WINDOW = 128
BLOCK = 128
Q_DIM = N_HEADS * HEAD_DIM
KV_DIM = N_KV_HEADS * HEAD_DIM
QKV_DIM = Q_DIM + 2 * KV_DIM
ALIBI_MAX_BIAS = 8.0

CHUNK = 128
SGU_HALF = 3 * D_MODEL
N_SGU_GROUPS = 8
SGU_GROUP_DIM = SGU_HALF // N_SGU_GROUPS

D_FF = 2816
CONV_WIDTH = 3

EPS = 1e-6

kernel_name = "hybrid_swa_sgu_convffn_trunk"


def rms_norm(x, g):
    xf = x.astype(jnp.float32)
    y = xf * lax.rsqrt(jnp.mean(xf * xf, axis=-1, keepdims=True) + EPS)
    return (y * g.astype(jnp.float32)).astype(x.dtype)


def layer_norm(x, g, b):
    xf = x.astype(jnp.float32)
    mu = jnp.mean(xf, axis=-1, keepdims=True)
    xc = xf - mu
    y = xc * lax.rsqrt(jnp.mean(xc * xc, axis=-1, keepdims=True) + EPS)
    return (y * g.astype(jnp.float32) + b.astype(jnp.float32)).astype(x.dtype)


def alibi_slopes():
    h = jnp.arange(1, N_HEADS + 1, dtype=jnp.float32)
    return jnp.exp2(-ALIBI_MAX_BIAS * h / N_HEADS)


def sliding_window_attention(h, w_qkv, b_qkv, sinks, w_o, b_o):
    B, S, _ = h.shape
    nb = S // BLOCK
    qkv = h @ w_qkv + b_qkv
    q, k, v = jnp.split(qkv, [Q_DIM, Q_DIM + KV_DIM], axis=-1)
    q = q.reshape(B, nb, BLOCK, N_KV_HEADS, Q_PER_KV, HEAD_DIM)
    k = k.reshape(B, nb, BLOCK, N_KV_HEADS, HEAD_DIM)
    v = v.reshape(B, nb, BLOCK, N_KV_HEADS, HEAD_DIM)

    def with_prev(t):
        prev = jnp.concatenate([jnp.zeros_like(t[:, :1]), t[:, :-1]], axis=1)
        return jnp.concatenate([prev, t], axis=2)

    kb, vb = with_prev(k), with_prev(v)
    scores = jnp.einsum("bnqgrd,bnkgd->bngrqk", q, kb).astype(jnp.float32) * (HEAD_DIM ** -0.5)

    qi = jnp.arange(BLOCK)[:, None]
    kj = jnp.arange(2 * BLOCK)[None, :]
    dist = qi + BLOCK - kj
    key_pos = jnp.arange(nb)[:, None, None] * BLOCK - BLOCK + kj[None]
    valid = (dist >= 0)[None] & (dist < WINDOW)[None] & (key_pos >= 0)

    slopes = alibi_slopes().reshape(N_KV_HEADS, Q_PER_KV)
    scores = scores - slopes[:, :, None, None] * dist.astype(jnp.float32)
    scores = jnp.where(valid[None, :, None, None], scores, -jnp.inf)

    sink = sinks.astype(jnp.float32).reshape(N_KV_HEADS, Q_PER_KV)[None, None, :, :, None, None]
    m = jnp.maximum(jnp.max(scores, axis=-1, keepdims=True), sink)
    p = jnp.exp(scores - m)
    probs = p / (jnp.sum(p, axis=-1, keepdims=True) + jnp.exp(sink - m))

    out = jnp.einsum("bngrqk,bnkgd->bnqgrd", probs.astype(h.dtype), vb)
    return out.reshape(B, S, Q_DIM) @ w_o + b_o


def chunked_sgu(h, w_in, ln_g, ln_b, w_s, b_s, w_out):
    B, S, _ = h.shape
    nc = S // CHUNK
    z = jax.nn.gelu(h @ w_in)
    u, v = jnp.split(z, 2, axis=-1)
    v = layer_norm(v, ln_g, ln_b)
    v = v.reshape(B, nc, CHUNK, N_SGU_GROUPS, SGU_GROUP_DIM)
    causal = jnp.tril(jnp.ones((CHUNK, CHUNK), dtype=bool))
    ws = jnp.where(causal[None], w_s, jnp.zeros_like(w_s))
    sv = jnp.einsum("gts,bcsgd->bctgd", ws, v) + b_s.T[None, None, :, :, None]
    return (u * sv.reshape(B, S, SGU_HALF)) @ w_out


def conv_gated_ffn(h, w_in, conv_w, conv_b, w_out):
    S = h.shape[1]
    g, u = jnp.split(h @ w_in, 2, axis=-1)
    gp = jnp.pad(g, ((0, 0), (CONV_WIDTH - 1, 0), (0, 0)))
    g = conv_b + sum(conv_w[k] * gp[:, k:k + S] for k in range(CONV_WIDTH))
    return (jax.nn.gelu(g) * u) @ w_out


def setup_inputs(seed: int = 0) -> dict:
    key = jax.random.key(seed)
    ks = jax.random.split(key, 24)
    f32 = jnp.float32

    def nrm(k, shape, scale):
        return jax.random.normal(k, shape, f32) * scale

    nA, nB = N_ATTN_LAYERS, N_SGU_LAYERS
    return {
        "x": nrm(ks[0], (BATCH, SEQ, D_MODEL), 1.0),
        "attn_w_qkv": nrm(ks[1], (nA, D_MODEL, QKV_DIM), D_MODEL ** -0.5),
        "attn_b_qkv": nrm(ks[2], (nA, QKV_DIM), 0.02),
        "attn_sinks": nrm(ks[3], (nA, N_HEADS), 1.0),
        "attn_w_o": nrm(ks[4], (nA, Q_DIM, D_MODEL), Q_DIM ** -0.5),
        "attn_b_o": nrm(ks[5], (nA, D_MODEL), 0.02),
        "sgu_w_in": nrm(ks[6], (nB, D_MODEL, 2 * SGU_HALF), D_MODEL ** -0.5),
        "sgu_ln_g": 1.0 + nrm(ks[7], (nB, SGU_HALF), 0.05),
        "sgu_ln_b": nrm(ks[8], (nB, SGU_HALF), 0.02),
        "sgu_w_s": nrm(ks[9], (nB, N_SGU_GROUPS, CHUNK, CHUNK), CHUNK ** -0.5),
        "sgu_b_s": 1.0 + nrm(ks[10], (nB, N_SGU_GROUPS, CHUNK), 0.05),
        "sgu_w_out": nrm(ks[11], (nB, SGU_HALF, D_MODEL), SGU_HALF ** -0.5),
        "ffn_w_in": nrm(ks[12], (DEPTH, D_MODEL, 2 * D_FF), D_MODEL ** -0.5),
        "ffn_conv_w": nrm(ks[13], (DEPTH, CONV_WIDTH, D_FF), CONV_WIDTH ** -0.5),
        "ffn_conv_b": nrm(ks[14], (DEPTH, D_FF), 0.02),
        "ffn_w_out": nrm(ks[15], (DEPTH, D_FF, D_MODEL), D_FF ** -0.5),
        "norm_mix_pre": 1.0 + nrm(ks[16], (DEPTH, D_MODEL), 0.05),
        "norm_mix_post": 1.0 + nrm(ks[17], (DEPTH, D_MODEL), 0.05),
        "norm_ffn_pre": 1.0 + nrm(ks[18], (DEPTH, D_MODEL), 0.05),
        "norm_ffn_post": 1.0 + nrm(ks[19], (DEPTH, D_MODEL), 0.05),
    }


def reference(x, attn_w_qkv, attn_b_qkv, attn_sinks, attn_w_o, attn_b_o,
              sgu_w_in, sgu_ln_g, sgu_ln_b, sgu_w_s, sgu_b_s, sgu_w_out,
              ffn_w_in, ffn_conv_w, ffn_conv_b, ffn_w_out,
              norm_mix_pre, norm_mix_post, norm_ffn_pre, norm_ffn_post):
    for i in range(DEPTH):
        j = i // N_MIXERS
        h = rms_norm(x, norm_mix_pre[i])
        if i % N_MIXERS == 0:
            h = sliding_window_attention(h, attn_w_qkv[j], attn_b_qkv[j], attn_sinks[j],
                                         attn_w_o[j], attn_b_o[j])
        else:
            h = chunked_sgu(h, sgu_w_in[j], sgu_ln_g[j], sgu_ln_b[j], sgu_w_s[j],
                            sgu_b_s[j], sgu_w_out[j])
        x = x + rms_norm(h, norm_mix_post[i])
        h = conv_gated_ffn(rms_norm(x, norm_ffn_pre[i]), ffn_w_in[i], ffn_conv_w[i],
                           ffn_conv_b[i], ffn_w_out[i])
        x = x + rms_norm(h, norm_ffn_post[i])
    return x
```

```cpp
#include <hip/hip_runtime.h>
#include <hip/hip_cooperative_groups.h>
#include <cstdio>
#include <cstdint>
namespace cg = cooperative_groups;

#define LAS __attribute__((address_space(3)))
typedef unsigned short bf16_t;
typedef short bf16x8 __attribute__((ext_vector_type(8)));
typedef float f32x4 __attribute__((ext_vector_type(4)));
typedef float f32x2 __attribute__((ext_vector_type(2)));
typedef unsigned u32x4 __attribute__((ext_vector_type(4)));
typedef unsigned u32x2 __attribute__((ext_vector_type(2)));

constexpr int DM = 1024, BATCH = 8, SEQ = 4096, MTOK = BATCH * SEQ, DEPTH = 4;
constexpr int QKV = 1536, QKD = 1280, KVD = 256, NH = 16;
constexpr int SH = 3072, NGRP = 8, GD = 384, CHK = 128;
constexpr int DFF = 2816;
constexpr float EPS = 1e-6f;
constexpr int NWAVES = 8, NTHREADS = 512;
constexpr int FFN_TPS = 17;

constexpr size_t MiB = 1u << 20;
constexpr size_t WS_PSUM = 1 * MiB;
constexpr size_t WS_PSQ = 4 * MiB;
constexpr size_t WS_CNT = 64 * 1024;
constexpr size_t WS_ROWSS = 7 * MiB;
constexpr size_t WS_SLOT = 26 * MiB + 512 * 1024;
constexpr size_t WS_WMIX = 8 * MiB;
constexpr size_t WS_WFFN = 28 * MiB;
constexpr size_t WS_XN = 48 * MiB;
constexpr size_t WS_BIG = 114 * MiB;
constexpr size_t WS_SBG0 = WS_BIG + 180 * MiB, WS_SBU0 = WS_BIG + 183 * MiB, WS_SB1 = WS_BIG + 186 * MiB;
constexpr size_t WS_END = WS_BIG + 384 * MiB;
constexpr size_t WM_A = 0;
constexpr size_t WM_B = 12 * MiB;
constexpr size_t WM_S = 18 * MiB;
constexpr size_t WF_A = 0;
constexpr size_t WF_B = 11 * MiB;

__device__ __forceinline__ unsigned cvt_pk_bf16(float lo, float hi) { unsigned r; asm volatile("v_cvt_pk_bf16_f32 %0, %1, %2" : "=v"(r) : "v"(lo), "v"(hi)); return r; }
__device__ __forceinline__ float bf_lo(unsigned w) { return __uint_as_float(w << 16); }
__device__ __forceinline__ float bf_hi(unsigned w) { return __uint_as_float(w & 0xffff0000u); }
__device__ __forceinline__ float gelu_tanh(float x) {
    const float t = x * (1.0f + 0.044715f * x * x) * (-2.0f * 0.7978845608028654f * 1.4426950408889634f);
    const float e = __builtin_amdgcn_exp2f(t);
    return x * __builtin_amdgcn_rcpf(1.0f + e);
}
__device__ __forceinline__ f32x2 gelu2(f32x2 x) {
    const float KK = -2.0f * 0.7978845608028654f * 1.4426950408889634f;
    const f32x2 p = (x * x) * (0.044715f * KK) + KK, t = x * p;
    f32x2 e; e.x = __builtin_amdgcn_exp2f(t.x); e.y = __builtin_amdgcn_exp2f(t.y);
    const f32x2 d = e + 1.0f;
    f32x2 r; r.x = __builtin_amdgcn_rcpf(d.x); r.y = __builtin_amdgcn_rcpf(d.y);
    return x * r;
}
__device__ __forceinline__ f32x4 gelu4(f32x4 v) { const f32x2 a = gelu2((f32x2){v[0], v[1]}), b = gelu2((f32x2){v[2], v[3]}); return (f32x4){a.x, a.y, b.x, b.y}; }
template <int CTRL> __device__ __forceinline__ float dpp_f(float v) { return __int_as_float(__builtin_amdgcn_update_dpp(0, __float_as_int(v), CTRL, 0xf, 0xf, true)); }
__device__ __forceinline__ float row16_sum(float v) { v += dpp_f<0xB1>(v); v += dpp_f<0x4E>(v); v += dpp_f<0x124>(v); v += dpp_f<0x128>(v); return v; }
__device__ __forceinline__ float wave_sum(float v) {
#pragma unroll
    for (int o = 1; o < 64; o <<= 1) v += __shfl_xor(v, o);
    return v;
}

namespace pg8 {
constexpr int BM = 256, BK = 64, HALF = 128, HTB = HALF * BK * 2, STAGE_BYTES = 8 * HTB, NXCD = 8, WGM = 8;
__host__ __device__ __forceinline__ int lds_byte(int r, int c) { const int st = (r >> 4) * 2 + (c >> 5), rr = r & 15, cc = c & 31, ob = rr * 64 + cc * 2; return st * 1024 + (ob ^ (((ob >> 9) & 1) << 5)); }
__host__ __device__ __forceinline__ void stage_rc(int b, int& R, int& C) { const int st = b / 1024, sb = b % 1024, swz = sb ^ (((sb >> 9) & 1) << 5); R = (st >> 1) * 16 + swz / 64; C = (st & 1) * 32 + (swz % 64) / 2; }
__host__ __device__ __forceinline__ int perm32(int rho) { const int n = rho >> 4, i = rho & 15; return 8 * (i >> 2) + 4 * n + (i & 3); }

struct Unit { int pm, pn, arow, brow, kind; };
struct Gemm { const bf16_t* A; const bf16_t* Bt; int K; const bf16_t* A1; const bf16_t* Bt1; };

struct Order {
    int nM, nN, nwg, G, c, ovl, nM1, nN1, nwg1;
    __device__ __forceinline__ void init(int nM_, int nN_, int G_, int c_, int ovl_, int nM1_ = 0, int nN1_ = 0) { nM = nM_; nN = nN_; nwg = nM * nN; G = G_; c = c_; ovl = ovl_; nM1 = nM1_; nN1 = nN1_; nwg1 = nM1 * nN1; }
    __device__ __forceinline__ static void deal(int wgid, int nwg_, int nM_, int nN_, int& pm, int& pn) {
        { const int q = nwg_ / NXCD, r = nwg_ % NXCD, xcd = wgid % NXCD, off = wgid / NXCD; wgid = (xcd < r ? xcd * (q + 1) : r * (q + 1) + (xcd - r) * q) + off; }
        const int nig = WGM * nN_, gid = wgid / nig, fm = gid * WGM, gsz = (nM_ - fm) < WGM ? (nM_ - fm) : WGM;
        pm = fm + ((wgid % nig) % gsz); pn = (wgid % nig) / gsz;
    }
    __device__ __forceinline__ bool next(int i, Unit& u) const {
        const long L = (long)i * G + c; if (L >= nwg + nwg1) return false;
        if (L < nwg) { deal((int)L, nwg, nM, nN, u.pm, u.pn); u.kind = 0; }
        else { deal((int)L - nwg, nwg1, nM1, nN1, u.pm, u.pn); u.kind = 1; }
        u.arow = u.pm * BM;
        u.brow = u.pn * BM;
        return true;
    }
};

template <class Epi>
__device__ __forceinline__ void gemm_phase(LAS unsigned char* lds, const Gemm g, const Order& S, Epi& E) {
    int tid = threadIdx.x; asm volatile("" : "+v"(tid));
    const int wid = __builtin_amdgcn_readfirstlane(tid >> 6), lane = tid & 63, wr = wid >> 2, wc = wid & 3, fr = lane & 15, fq = lane >> 4;
    const int K = g.K, nt = K / BK;
    unsigned voffA[2], voffB[2];
#pragma unroll
    for (int i = 0; i < 2; ++i) { int R, C; stage_rc(tid * 16 + i * 8192, R, C); const int Rb = (R & ~31) + perm32(R & 31);
        voffA[i] = (unsigned)(R * K + C) * 2u; voffB[i] = (unsigned)(Rb * K + C) * 2u; }
    const size_t kstep = (size_t)(BK * 2);
    const size_t hstep = (size_t)HALF * K * 2;
    const long rowb = (long)K * 2;
    const unsigned ldsw = (unsigned)wid * 1024u;
    const int aoff = lds_byte(wr * 64 + fr, fq * 8), boff = lds_byte(wc * 32 + fr, fq * 8);
#define PG8_SA(b, h) (((b) * 2 + (h)) * HTB)
#define PG8_SB(b, h) ((4 + (b) * 2 + (h)) * HTB)
#define PG8_STAGE(bufoff, gbase, voff) do { _Pragma("unroll") for (int _i = 0; _i < 2; ++_i) \
        __builtin_amdgcn_global_load_lds((const unsigned*)((const char*)(gbase) + (voff)[_i]), (LAS unsigned*)(lds + (bufoff) + ldsw + _i * 8192), 16, 0, 0); } while (0)
#define PG8_LDA(dst, b, h) do { _Pragma("unroll") for (int m = 0; m < 4; ++m) _Pragma("unroll") for (int k = 0; k < 2; ++k) dst[m][k] = *(const LAS bf16x8*)(lds + PG8_SA(b, h) + aoff + m * 2048 + k * 1024); } while (0)
#define PG8_LDB(dst, b, h) do { _Pragma("unroll") for (int n = 0; n < 2; ++n) _Pragma("unroll") for (int k = 0; k < 2; ++k) dst[n][k] = *(const LAS bf16x8*)(lds + PG8_SB(b, h) + boff + n * 2048 + k * 1024); } while (0)
#define PG8_MMA(ai, bj, At, Bt) do { __builtin_amdgcn_s_setprio(1); _Pragma("unroll") for (int m = 0; m < 4; ++m) _Pragma("unroll") for (int n = 0; n < 2; ++n) _Pragma("unroll") for (int k = 0; k < 2; ++k) \
        acc[ai][bj][m][n] = __builtin_amdgcn_mfma_f32_16x16x32_bf16(Bt[n][k], At[m][k], acc[ai][bj][m][n], 0, 0, 0); __builtin_amdgcn_s_setprio(0); } while (0)
#define PG8_WAIT_V(n) asm volatile("s_waitcnt vmcnt(" #n ")" ::: "memory")
#define PG8_WAIT_L(n) asm volatile("s_waitcnt lgkmcnt(" #n ")" ::: "memory")
#define PG8_BAR __builtin_amdgcn_s_barrier()
#define PG8_SCHED __builtin_amdgcn_sched_barrier(0)
    Unit cur, nxt; int ui = 0;
    if (!S.next(0, cur)) return;
    float zf = 0.f; asm volatile("" : "+v"(zf));
    f32x4 acc[2][2][4][2];
#pragma unroll
    for (int a = 0; a < 2; ++a)
#pragma unroll
        for (int b = 0; b < 2; ++b)
#pragma unroll
            for (int m = 0; m < 4; ++m)
#pragma unroll
                for (int n = 0; n < 2; ++n) acc[a][b][m][n] = (f32x4){zf, zf, zf, zf};
    bf16x8 At[4][2], B0[2][2], B1[2][2];
    const char* cA = (const char*)(cur.kind ? g.A1 : g.A) + (long)cur.arow * rowb; const char* cB = (const char*)(cur.kind ? g.Bt1 : g.Bt) + (long)cur.brow * rowb;
    PG8_STAGE(PG8_SB(0, 0), cB, voffB); PG8_STAGE(PG8_SB(0, 1), cB + hstep, voffB); PG8_STAGE(PG8_SA(0, 0), cA, voffA); PG8_STAGE(PG8_SA(0, 1), cA + hstep, voffA);
    if (wr == 1) PG8_BAR;
    PG8_WAIT_V(2); PG8_BAR;
    PG8_STAGE(PG8_SB(1, 0), cB + kstep, voffB); PG8_STAGE(PG8_SA(1, 0), cA + kstep, voffA); PG8_STAGE(PG8_SB(1, 1), cB + hstep + kstep, voffB);
    PG8_WAIT_V(6); PG8_BAR;
    for (;;) {
        const bool has_next = S.next(ui + 1, nxt);
        const char* nA = has_next ? (const char*)(nxt.kind ? g.A1 : g.A) + (long)nxt.arow * rowb : cA; const char* nB = has_next ? (const char*)(nxt.kind ? g.Bt1 : g.Bt) + (long)nxt.brow * rowb : cB;
        for (int t = 0; t < nt; t += 2) {
            const bool last = (t == nt - 2);
            const char* a1 = cA + (size_t)(t + 1) * kstep;
            const char* a2 = last ? nA : cA + (size_t)(t + 2) * kstep; const char* b2 = last ? nB : cB + (size_t)(t + 2) * kstep;
            const char* a3 = a2 + kstep; const char* b3 = b2 + kstep;
            PG8_LDB(B0, 0, 0); PG8_LDB(B1, 0, 1); PG8_SCHED; PG8_LDA(At, 0, 0); PG8_STAGE(PG8_SA(1, 1), a1 + hstep, voffA);
            PG8_WAIT_V(8); PG8_WAIT_L(0); PG8_BAR; PG8_MMA(0, 0, At, B0); PG8_MMA(0, 1, At, B1); PG8_BAR; PG8_SCHED;
            PG8_LDA(At, 0, 1); PG8_STAGE(PG8_SB(0, 0), b2, voffB); PG8_STAGE(PG8_SB(0, 1), b2 + hstep, voffB); PG8_STAGE(PG8_SA(0, 0), a2, voffA);
            PG8_WAIT_V(8); PG8_WAIT_L(0); PG8_BAR; PG8_MMA(1, 0, At, B0); PG8_MMA(1, 1, At, B1); PG8_BAR; PG8_SCHED;
            PG8_LDB(B0, 1, 0); PG8_LDB(B1, 1, 1); PG8_SCHED; PG8_LDA(At, 1, 0); PG8_STAGE(PG8_SA(0, 1), a2 + hstep, voffA);
            PG8_WAIT_V(8); PG8_WAIT_L(0); PG8_BAR; PG8_MMA(0, 0, At, B0); PG8_MMA(0, 1, At, B1); PG8_BAR; PG8_SCHED;
            PG8_LDA(At, 1, 1); PG8_STAGE(PG8_SB(1, 0), b3, voffB); PG8_STAGE(PG8_SB(1, 1), b3 + hstep, voffB); PG8_STAGE(PG8_SA(1, 0), a3, voffA);
            PG8_WAIT_V(8); PG8_WAIT_L(0); PG8_BAR; PG8_MMA(1, 0, At, B0); PG8_MMA(1, 1, At, B1); PG8_BAR; PG8_SCHED;
        }
        if (wr == 0) PG8_BAR;
        E(acc, cur, wr, wc, fr, fq, lane);
        if (!has_next) break;
#pragma unroll
        for (int a = 0; a < 2; ++a)
#pragma unroll
            for (int b = 0; b < 2; ++b)
#pragma unroll
                for (int m = 0; m < 4; ++m)
#pragma unroll
                    for (int n = 0; n < 2; ++n) acc[a][b][m][n] = (f32x4){zf, zf, zf, zf};
        cur = nxt; cA = nA; cB = nB; ++ui;
        if (wr == 1) PG8_BAR;
    }
    PG8_WAIT_V(0);
    PG8_BAR;
#undef PG8_SA
#undef PG8_SB
#undef PG8_STAGE
#undef PG8_LDA
#undef PG8_LDB
#undef PG8_MMA
#undef PG8_WAIT_V
#undef PG8_WAIT_L
#undef PG8_BAR
#undef PG8_SCHED
}
}

struct Params { const float* in[20]; float* out; unsigned char* ws; };
#define KP (*(const Params*)__builtin_amdgcn_kernarg_segment_ptr())
__device__ __forceinline__ float rstd_of(const float* rowss, int row) { const f32x4 p = *(const f32x4*)(rowss + (size_t)row * 4); return __builtin_amdgcn_rsqf(((p[0] + p[1]) + (p[2] + p[3])) * (1.f / DM) + EPS); }
struct EpiStore {
    int attn, j;
    __device__ __forceinline__ void operator()(f32x4 (&acc)[2][2][4][2], const pg8::Unit& u, int wr, int wc, int fr, int fq, int lane) const {
        unsigned char* ws = KP.ws;
        bf16_t* O = (bf16_t*)(ws + WS_BIG); const long ldc = attn ? (long)QKD : (long)SH; const float* cbias = attn ? KP.in[2] + (size_t)j * QKV : nullptr; const int act = attn ? 0 : 1;
        const float* rowss = (const float*)(ws + WS_ROWSS);
        const int row0 = u.pm * 256 + wr * 64 + fr, col0 = u.pn * 256 + wc * 32 + 8 * fq;
        float rs[2][4];
#pragma unroll
        for (int ai = 0; ai < 2; ++ai)
#pragma unroll
            for (int m = 0; m < 4; ++m) rs[ai][m] = rstd_of(rowss, row0 + ai * 128 + m * 16);
        f32x4 bv[2][2];
#pragma unroll
        for (int bj = 0; bj < 2; ++bj)
#pragma unroll
            for (int n = 0; n < 2; ++n) bv[bj][n] = cbias ? *(const f32x4*)(cbias + col0 + bj * 128 + 4 * n) : (f32x4){0.f, 0.f, 0.f, 0.f};
#pragma unroll
        for (int ai = 0; ai < 2; ++ai)
#pragma unroll
            for (int m = 0; m < 4; ++m) { bf16_t* rowp = O + (size_t)(row0 + ai * 128 + m * 16) * ldc + col0;
#pragma unroll
                for (int bj = 0; bj < 2; ++bj) { f32x4 v0 = acc[ai][bj][m][0] * rs[ai][m] + bv[bj][0], v1 = acc[ai][bj][m][1] * rs[ai][m] + bv[bj][1];
                    if (act) { v0 = gelu4(v0); v1 = gelu4(v1); }
                    u32x4 w; w.x = cvt_pk_bf16(v0[0], v0[1]); w.y = cvt_pk_bf16(v0[2], v0[3]); w.z = cvt_pk_bf16(v1[0], v1[1]); w.w = cvt_pk_bf16(v1[2], v1[3]);
                    *(u32x4*)(rowp + bj * 128) = w; } }
    }
};
struct EpiVT {
    int attn, j;
    __device__ __forceinline__ void operator()(f32x4 (&acc)[2][2][4][2], const pg8::Unit& u, int wr, int wc, int fr, int fq, int lane) const {
        unsigned char* ws = KP.ws;
        bf16_t* O = (bf16_t*)(ws + WS_BIG + (attn ? 80 : 192) * MiB); const float* rbias = attn ? KP.in[2] + (size_t)j * QKV + QKD : nullptr; const int act = attn ? 0 : 1;
        float* psum = attn ? nullptr : (float*)(ws + WS_PSUM); float* psq = attn ? nullptr : (float*)(ws + WS_PSQ); const float* rowss = (const float*)(ws + WS_ROWSS);
        const int row0 = u.pm * 256 + wr * 64 + fr, col0 = u.pn * 256 + wc * 32 + 8 * fq;
#pragma unroll
        for (int bj = 0; bj < 2; ++bj) {
            f32x4 c0, c1v;
#pragma unroll
            for (int i = 0; i < 4; ++i) { c0[i] = rstd_of(rowss, col0 + bj * 128 + i); c1v[i] = rstd_of(rowss, col0 + bj * 128 + 4 + i); }
            f32x4 s0 = (f32x4){0.f, 0.f, 0.f, 0.f}, s1 = s0, q0 = s0, q1 = s0;
#pragma unroll
            for (int ai = 0; ai < 2; ++ai)
#pragma unroll
                for (int m = 0; m < 4; ++m) { const int row = row0 + ai * 128 + m * 16; const float rb = rbias ? rbias[row] : 0.f;
                    f32x4 v0 = acc[ai][bj][m][0] * c0 + rb, v1 = acc[ai][bj][m][1] * c1v + rb;
                    if (act) { v0 = gelu4(v0); v1 = gelu4(v1); }
                    s0 += v0; s1 += v1; q0 += v0 * v0; q1 += v1 * v1;
                    u32x4 w; w.x = cvt_pk_bf16(v0[0], v0[1]); w.y = cvt_pk_bf16(v0[2], v0[3]); w.z = cvt_pk_bf16(v1[0], v1[1]); w.w = cvt_pk_bf16(v1[2], v1[3]);
                    *(u32x4*)(O + (size_t)row * MTOK + col0 + bj * 128) = w; }
            if (psum) {
#pragma unroll
                for (int i = 0; i < 4; ++i) { s0[i] = row16_sum(s0[i]); s1[i] = row16_sum(s1[i]); q0[i] = row16_sum(q0[i]); q1[i] = row16_sum(q1[i]); }
                if (fr == 0) { const size_t p = (size_t)(u.pm * 2 + wr) * MTOK + col0 + bj * 128;
                    *(f32x4*)(psum + p) = s0; *(f32x4*)(psum + p + 4) = s1; *(f32x4*)(psq + p) = q0; *(f32x4*)(psq + p + 4) = q1; }
            }
        }
    }
};
struct EpiG1 {
    int attn, j;
    __device__ __forceinline__ void operator()(f32x4 (&acc)[2][2][4][2], const pg8::Unit& u, int wr, int wc, int fr, int fq, int lane) const {
        if (u.kind == 0) { EpiStore e{attn, j}; e(acc, u, wr, wc, fr, fq, lane); } else { EpiVT e{attn, j}; e(acc, u, wr, wc, fr, fq, lane); }
    }
};
struct EpiConv {
    int L; LAS float* X;
    __device__ __forceinline__ void operator()(f32x4 (&acc)[2][2][4][2], const pg8::Unit& u, int wr, int wc, int fr, int fq, int lane) const {
        unsigned char* ws = KP.ws;
        bf16_t* O = (bf16_t*)(ws + WS_BIG); const float* cw = KP.in[13] + (size_t)L * 3 * DFF; const float* cb = KP.in[14] + (size_t)L * DFF; const float* rowss = (const float*)(ws + WS_ROWSS);
        const bool seq_start = (u.pm & 15) == 0;
#pragma unroll
        for (int ai = 0; ai < 2; ++ai)
#pragma unroll
            for (int m = 0; m < 4; ++m) { const float r = rstd_of(rowss, u.pm * 256 + ai * 128 + wr * 64 + m * 16 + fr);
#pragma unroll
                for (int bj = 0; bj < 2; ++bj)
#pragma unroll
                    for (int n = 0; n < 2; ++n) acc[ai][bj][m][n] *= r; }
        const int cl = wc * 32 + 8 * fq;
        const int f0 = u.pn * 128 + cl;
        if (fr >= 14) {
#pragma unroll
            for (int ai = 0; ai < 2; ++ai)
#pragma unroll
                for (int n = 0; n < 2; ++n) *(LAS f32x4*)(X + ((ai * 2 + wr) * 2 + (fr - 14)) * 128 + cl + 4 * n) = acc[ai][0][3][n];
            if (wr == 1) {
                float* sb1 = (float*)(ws + WS_SB1) + (size_t)(u.pm * 2 + (fr - 14)) * DFF + f0;
#pragma unroll
                for (int n = 0; n < 2; ++n) *(f32x4*)(sb1 + 4 * n) = acc[1][0][3][n];
            }
        }
        if (wr == 0 && fr < 2 && !seq_start) {
            float* sg = (float*)(ws + WS_SBG0) + (size_t)(u.pm * 2 + fr) * DFF + f0; float* su = (float*)(ws + WS_SBU0) + (size_t)(u.pm * 2 + fr) * DFF + f0;
#pragma unroll
            for (int n = 0; n < 2; ++n) { *(f32x4*)(sg + 4 * n) = acc[0][0][0][n]; *(f32x4*)(su + 4 * n) = acc[0][1][0][n]; }
        }
        asm volatile("s_waitcnt lgkmcnt(0)" ::: "memory"); __builtin_amdgcn_s_barrier(); asm volatile("" ::: "memory");
        u32x2 hp[2][4];
#pragma unroll
        for (int n = 0; n < 2; ++n) {
            const f32x4 w0 = *(const f32x4*)(cw + f0 + 4 * n), w1 = *(const f32x4*)(cw + DFF + f0 + 4 * n), w2 = *(const f32x4*)(cw + 2 * DFF + f0 + 4 * n), wb = *(const f32x4*)(cb + f0 + 4 * n);
#pragma unroll
            for (int ai = 0; ai < 2; ++ai) {
                const int blk = ai * 2 + wr;
                f32x4 pr1 = (f32x4){0.f, 0.f, 0.f, 0.f}, pr2 = pr1;
                if (blk > 0 && fr < 2) { pr2 = *(const LAS f32x4*)(X + ((blk - 1) * 2 + fr) * 128 + cl + 4 * n); pr1 = *(const LAS f32x4*)(X + ((blk - 1) * 2 + 1) * 128 + cl + 4 * n); }
#pragma unroll
                for (int m = 0; m < 4; ++m) {
                    const int lr = ai * 128 + wr * 64 + m * 16 + fr;
                    const f32x4 cur = acc[ai][0][m][n];
                    f32x4 r1, r2;
#pragma unroll
                    for (int i = 0; i < 4; ++i) { r1[i] = dpp_f<0x121>(cur[i]); r2[i] = dpp_f<0x122>(cur[i]); }
                    const f32x4 p1 = (fr >= 1) ? r1 : pr1, p2 = (fr >= 2) ? r2 : pr2;
                    pr1 = r1; pr2 = r2;
                    const f32x4 gc = wb + w0 * p2 + w1 * p1 + w2 * cur;
                    const f32x4 hv = gelu4(gc) * acc[ai][1][m][n];
                    u32x2 w; w.x = cvt_pk_bf16(hv[0], hv[1]); w.y = cvt_pk_bf16(hv[2], hv[3]);
                    if (n == 0) hp[ai][m] = w;
                    else if (lr >= 2 || seq_start) *(u32x4*)(O + (size_t)(u.pm * 256 + lr) * DFF + f0) = (u32x4){hp[ai][m].x, hp[ai][m].y, w.x, w.y};
                }
            }
        }
    }
};
__device__ __forceinline__ void ffn_fixup(int pm, int L, int tid) {
    if ((pm & 15) == 0) return;
    unsigned char* ws = KP.ws;
    const float* sg0 = (const float*)(ws + WS_SBG0) + (size_t)pm * 2 * DFF; const float* su0 = (const float*)(ws + WS_SBU0) + (size_t)pm * 2 * DFF; const float* sp = (const float*)(ws + WS_SB1) + (size_t)(pm - 1) * 2 * DFF;
    const float* cw = KP.in[13] + (size_t)L * 3 * DFF; const float* cb = KP.in[14] + (size_t)L * DFF; bf16_t* O = (bf16_t*)(ws + WS_BIG);
    for (int idx = tid; idx < 2 * (DFF / 4); idx += NTHREADS) {
        const int lr = idx / (DFF / 4), f = 4 * (idx % (DFF / 4));
        const f32x4 cur = *(const f32x4*)(sg0 + lr * DFF + f), uu = *(const f32x4*)(su0 + lr * DFF + f);
        const f32x4 p1 = lr == 0 ? *(const f32x4*)(sp + DFF + f) : *(const f32x4*)(sg0 + f);
        const f32x4 p2 = lr == 0 ? *(const f32x4*)(sp + f) : *(const f32x4*)(sp + DFF + f);
        const f32x4 gc = *(const f32x4*)(cb + f) + *(const f32x4*)(cw + f) * p2 + *(const f32x4*)(cw + DFF + f) * p1 + *(const f32x4*)(cw + 2 * DFF + f) * cur;
        const f32x4 hv = gelu4(gc) * uu;
        u32x2 w; w.x = cvt_pk_bf16(hv[0], hv[1]); w.y = cvt_pk_bf16(hv[2], hv[3]);
        *(u32x2*)(O + (size_t)(pm * 256 + lr) * DFF + f) = w;
    }
}
struct EpiResid {
    int hl; LAS float* Pt; LAS float* St;
    __device__ __forceinline__ void operator()(f32x4 (&acc)[2][2][4][2], const pg8::Unit& u, int wr, int wc, int fr, int fq, int lane) const {
        unsigned char* ws = KP.ws; const int L = hl >> 1;
        bf16_t* XB = (bf16_t*)(ws + WS_XN); float* OUT = (hl + 1 == 2 * DEPTH) ? KP.out : nullptr;
        const float* cbias = (hl & 3) == 0 ? KP.in[5] + (size_t)(L >> 1) * DM : nullptr;
        const float* gpost = ((hl & 1) == 0 ? KP.in[17] : KP.in[19]) + (size_t)L * DM;
        unsigned long long* slots = (unsigned long long*)(ws + WS_SLOT); const unsigned tag = (unsigned)(hl + 1); float* rowss = (float*)(ws + WS_ROWSS);
        const int wid = wr * 4 + wc, tid = wid * 64 + lane;
        const int row0 = u.pm * 256 + wr * 64 + fr, col0 = u.pn * 256 + wc * 32 + 8 * fq;
        if (cbias) {
#pragma unroll
            for (int bj = 0; bj < 2; ++bj)
#pragma unroll
                for (int n = 0; n < 2; ++n) { const f32x4 bv = *(const f32x4*)(cbias + col0 + bj * 128 + 4 * n);
#pragma unroll
                    for (int ai = 0; ai < 2; ++ai)
#pragma unroll
                        for (int m = 0; m < 4; ++m) acc[ai][bj][m][n] += bv; }
        }
#pragma unroll
        for (int ai = 0; ai < 2; ++ai)
#pragma unroll
            for (int m = 0; m < 4; ++m) { float sq = 0.f;
#pragma unroll
                for (int bj = 0; bj < 2; ++bj)
#pragma unroll
                    for (int n = 0; n < 2; ++n) { const f32x4 v = acc[ai][bj][m][n]; sq += (v[0] * v[0] + v[1] * v[1]) + (v[2] * v[2] + v[3] * v[3]); }
                sq += __shfl_xor(sq, 16); sq += __shfl_xor(sq, 32);
                if (fq == 0) Pt[(ai * 128 + wr * 64 + m * 16 + fr) * 4 + wc] = sq; }
        asm volatile("s_waitcnt lgkmcnt(0)" ::: "memory"); __builtin_amdgcn_s_barrier(); asm volatile("" ::: "memory");
        if (tid < 256) {
            const f32x4 p = *(const LAS f32x4*)(Pt + tid * 4);
            __hip_atomic_store(slots + (size_t)(u.pm * 256 + tid) * 4 + u.pn, ((unsigned long long)tag << 32) | (unsigned long long)__float_as_uint((p[0] + p[1]) + (p[2] + p[3])), __ATOMIC_RELAXED, __HIP_MEMORY_SCOPE_AGENT);
        }
        asm volatile("" ::: "memory");
        u32x4 xr[4][2];
#pragma unroll
        for (int m = 0; m < 4; ++m)
#pragma unroll
            for (int bj = 0; bj < 2; ++bj) xr[m][bj] = *(const u32x4*)(XB + (size_t)(row0 + m * 16) * DM + col0 + bj * 128);
        f32x4 gp[2][2];
#pragma unroll
        for (int bj = 0; bj < 2; ++bj)
#pragma unroll
            for (int n = 0; n < 2; ++n) gp[bj][n] = *(const f32x4*)(gpost + col0 + bj * 128 + 4 * n);
        if (tid < 256) {
            const unsigned long long* sl = slots + (size_t)(u.pm * 256 + tid) * 4; float t = 0.f; unsigned sp = 0;
            for (;;) {
                const unsigned long long a0 = __hip_atomic_load(sl + 0, __ATOMIC_RELAXED, __HIP_MEMORY_SCOPE_AGENT), a1 = __hip_atomic_load(sl + 1, __ATOMIC_RELAXED, __HIP_MEMORY_SCOPE_AGENT),
                                         a2 = __hip_atomic_load(sl + 2, __ATOMIC_RELAXED, __HIP_MEMORY_SCOPE_AGENT), a3 = __hip_atomic_load(sl + 3, __ATOMIC_RELAXED, __HIP_MEMORY_SCOPE_AGENT);
                const bool ok = ((unsigned)(a0 >> 32) == tag) && ((unsigned)(a1 >> 32) == tag) && ((unsigned)(a2 >> 32) == tag) && ((unsigned)(a3 >> 32) == tag);
                t = (__uint_as_float((unsigned)a0) + __uint_as_float((unsigned)a1)) + (__uint_as_float((unsigned)a2) + __uint_as_float((unsigned)a3));
                if (__builtin_amdgcn_ballot_w64(!ok) == 0ull || ++sp > (1u << 22)) break;
                __builtin_amdgcn_s_sleep(1);
            }
            St[tid] = __builtin_amdgcn_rsqf(t * (1.f / DM) + EPS);
        }
        asm volatile("s_waitcnt lgkmcnt(0)" ::: "memory"); __builtin_amdgcn_s_barrier(); asm volatile("" ::: "memory");
#pragma unroll
        for (int ai = 0; ai < 2; ++ai) {
            if (ai == 1) {
                asm volatile("" ::: "memory");
#pragma unroll
                for (int m = 0; m < 4; ++m)
#pragma unroll
                    for (int bj = 0; bj < 2; ++bj) xr[m][bj] = *(const u32x4*)(XB + (size_t)(row0 + 128 + m * 16) * DM + col0 + bj * 128);
            }
#pragma unroll
            for (int m = 0; m < 4; ++m) { const int lr = ai * 128 + wr * 64 + m * 16 + fr; const float r = St[lr]; float sq = 0.f;
                const size_t off = (size_t)(u.pm * 256 + lr) * DM + col0;
#pragma unroll
                for (int bj = 0; bj < 2; ++bj) { const u32x4 xw = xr[m][bj];
                    const f32x4 x0 = (f32x4){bf_lo(xw.x), bf_hi(xw.x), bf_lo(xw.y), bf_hi(xw.y)}, x1 = (f32x4){bf_lo(xw.z), bf_hi(xw.z), bf_lo(xw.w), bf_hi(xw.w)};
                    const f32x4 o0 = x0 + acc[ai][bj][m][0] * r * gp[bj][0], o1 = x1 + acc[ai][bj][m][1] * r * gp[bj][1];
                    sq += ((o0[0] * o0[0] + o0[1] * o0[1]) + (o0[2] * o0[2] + o0[3] * o0[3])) + ((o1[0] * o1[0] + o1[1] * o1[1]) + (o1[2] * o1[2] + o1[3] * o1[3]));
                    if (OUT) { *(f32x4*)(OUT + off + bj * 128) = o0; *(f32x4*)(OUT + off + bj * 128 + 4) = o1; }
                    else { u32x4 w; w.x = cvt_pk_bf16(o0[0], o0[1]); w.y = cvt_pk_bf16(o0[2], o0[3]); w.z = cvt_pk_bf16(o1[0], o1[1]); w.w = cvt_pk_bf16(o1[2], o1[3]); *(u32x4*)(XB + off + bj * 128) = w; } }
                sq += __shfl_xor(sq, 16); sq += __shfl_xor(sq, 32);
                if (fq == 0) Pt[lr * 4 + wc] = sq; }
        }
        asm volatile("s_waitcnt lgkmcnt(0)" ::: "memory"); __builtin_amdgcn_s_barrier(); asm volatile("" ::: "memory");
        if (tid < 256) { const f32x4 p = *(const LAS f32x4*)(Pt + tid * 4); rowss[(size_t)(u.pm * 256 + tid) * 4 + u.pn] = (p[0] + p[1]) + (p[2] + p[3]); }
    }
};

struct ConvSrc { const float* W; int K, N; bf16_t* WT; int mode; const float* gk; };
__device__ __forceinline__ void conv_load(const ConvSrc& c, int item, int lane, float (&R)[32]) {
    const int nblk = c.N / 32, kb = item / nblk, nb = item % nblk, k0 = 64 * kb, n0 = 32 * nb;
#pragma unroll
    for (int i = 0; i < 32; ++i) { const int kk = 2 * i + (lane >> 5); const float gv = c.gk ? c.gk[k0 + kk] : 1.f; R[i] = c.W[(size_t)(k0 + kk) * c.N + n0 + (lane & 31)] * gv; }
}
__device__ __forceinline__ void conv_store(const ConvSrc& c, int item, int lane, LAS float* scr, const float (&R)[32]) {
    const int nblk = c.N / 32, kb = item / nblk, nb = item % nblk, k0 = 64 * kb, n0 = 32 * nb;
#pragma unroll
    for (int i = 0; i < 32; ++i) scr[(2 * i + (lane >> 5)) * 33 + (lane & 31)] = R[i];
}
__device__ __forceinline__ void conv_finish(const ConvSrc& c, int item, int lane, LAS float* scr) {
    const int nblk = c.N / 32, kb = item / nblk, nb = item % nblk, k0 = 64 * kb, n0 = 32 * nb;
    asm volatile("s_waitcnt lgkmcnt(0)" ::: "memory");
    int d0 = n0;
    if (c.mode == 1) { const int f = (n0 < DFF) ? n0 : n0 - DFF; d0 = 256 * (f >> 7) + (f & 127) + ((n0 < DFF) ? 0 : 128); }
    const int cc = lane & 7;
#pragma unroll
    for (int j = 0; j < 4; ++j) { const int n = (lane >> 3) + 8 * j; const LAS float* sp = scr + (8 * cc) * 33 + n;
        u32x4 o; o.x = cvt_pk_bf16(sp[0 * 33], sp[1 * 33]); o.y = cvt_pk_bf16(sp[2 * 33], sp[3 * 33]); o.z = cvt_pk_bf16(sp[4 * 33], sp[5 * 33]); o.w = cvt_pk_bf16(sp[6 * 33], sp[7 * 33]);
        *(u32x4*)(c.WT + (size_t)(d0 + n) * c.K + k0 + 8 * cc) = o; }
    asm volatile("s_waitcnt lgkmcnt(0)" ::: "memory");
}
__device__ __forceinline__ ConvSrc conv_pick(const ConvSrc a, const ConvSrc b, bool first) {
    ConvSrc c; c.W = first ? a.W : b.W; c.K = first ? a.K : b.K; c.N = first ? a.N : b.N; c.WT = first ? a.WT : b.WT; c.mode = first ? a.mode : b.mode; c.gk = first ? a.gk : b.gk; return c;
}
__device__ __forceinline__ void convert_pair(const ConvSrc a, int I1, const ConvSrc b, int I2, LAS float* scr, int gw, int NGW, int lane) {
    float R[32];
    int it = gw;
    if (it < I1 + I2) { const ConvSrc c = conv_pick(a, b, it < I1); conv_load(c, it < I1 ? it : it - I1, lane, R); }
    while (it < I1 + I2) {
        const int nx = it + NGW;
        const ConvSrc c = conv_pick(a, b, it < I1); const int ci = it < I1 ? it : it - I1;
        conv_store(c, ci, lane, scr, R);
        if (nx < I1 + I2) { const ConvSrc cn = conv_pick(a, b, nx < I1); conv_load(cn, nx < I1 ? nx : nx - I1, lane, R); }
        conv_finish(c, ci, lane, scr);
        it = nx;
    }
}

__device__ __forceinline__ void convert_mixer(const Params& P, int L, LAS float* scr, int gw, int NGW, int lane) {
    const int j = L >> 1;
    unsigned char* wm = P.ws + WS_WMIX;
    if ((L & 1) == 0) {
        const ConvSrc a{P.in[1] + (size_t)j * DM * QKV, DM, QKV, (bf16_t*)(wm + WM_A), 0, P.in[16] + (size_t)L * DM};
        const ConvSrc b{P.in[4] + (size_t)j * DM * DM, DM, DM, (bf16_t*)(wm + WM_B), 0, nullptr};
        convert_pair(a, (DM / 64) * (QKV / 32), b, (DM / 64) * (DM / 32), scr, gw, NGW, lane);
    } else {
        const ConvSrc a{P.in[6] + (size_t)j * DM * 2 * SH, DM, 2 * SH, (bf16_t*)(wm + WM_A), 0, P.in[16] + (size_t)L * DM};
        const ConvSrc b{P.in[11] + (size_t)j * SH * DM, SH, DM, (bf16_t*)(wm + WM_B), 0, nullptr};
        convert_pair(a, (DM / 64) * (2 * SH / 32), b, (SH / 64) * (DM / 32), scr, gw, NGW, lane);
        const float* wsp = P.in[9] + (size_t)j * NGRP * CHK * CHK;
        bf16_t* wsb = (bf16_t*)(wm + WM_S);
        for (int e = (gw * 64 + lane) * 4; e < NGRP * CHK * CHK; e += NGW * 64 * 4) {
            const f32x4 v = *(const f32x4*)(wsp + e); const int t = (e >> 7) & 127, s0 = e & 127;
            u32x2 o; o.x = cvt_pk_bf16(s0 <= t ? v[0] : 0.f, s0 + 1 <= t ? v[1] : 0.f); o.y = cvt_pk_bf16(s0 + 2 <= t ? v[2] : 0.f, s0 + 3 <= t ? v[3] : 0.f);
            *(u32x2*)(wsb + e) = o;
        }
    }
}
__device__ __forceinline__ void convert_ffn(const Params& P, int L, LAS float* scr, int gw, int NGW, int lane) {
    unsigned char* wf = P.ws + WS_WFFN;
    const ConvSrc a{P.in[12] + (size_t)L * DM * 2 * DFF, DM, 2 * DFF, (bf16_t*)(wf + WF_A), 1, P.in[18] + (size_t)L * DM};
    const ConvSrc b{P.in[15] + (size_t)L * DFF * DM, DFF, DM, (bf16_t*)(wf + WF_B), 0, nullptr};
    convert_pair(a, (DM / 64) * (2 * DFF / 32), b, (DFF / 64) * (DM / 32), scr, gw, NGW, lane);
}

__device__ __forceinline__ void xb0_phase(const float* x, bf16_t* xb, float* rowss, int gw, int NGW, int lane) {
    for (int r = gw; r < MTOK; r += 2 * NGW) {
        f32x4 v[2][4];
#pragma unroll
        for (int k = 0; k < 2; ++k)
#pragma unroll
            for (int j = 0; j < 2; ++j) { const float* p = x + (size_t)(r + k * NGW) * DM + 8 * lane + 512 * j;
                v[k][2 * j] = __builtin_nontemporal_load((const f32x4*)p); v[k][2 * j + 1] = __builtin_nontemporal_load((const f32x4*)(p + 4)); }
#pragma unroll
        for (int k = 0; k < 2; ++k) {
            float ss = 0.f;
#pragma unroll
            for (int j = 0; j < 4; ++j) ss += (v[k][j][0] * v[k][j][0] + v[k][j][1] * v[k][j][1]) + (v[k][j][2] * v[k][j][2] + v[k][j][3] * v[k][j][3]);
            ss = wave_sum(ss);
            bf16_t* o = xb + (size_t)(r + k * NGW) * DM + 8 * lane;
#pragma unroll
            for (int j = 0; j < 2; ++j) { u32x4 w; w.x = cvt_pk_bf16(v[k][2 * j][0], v[k][2 * j][1]); w.y = cvt_pk_bf16(v[k][2 * j][2], v[k][2 * j][3]);
                w.z = cvt_pk_bf16(v[k][2 * j + 1][0], v[k][2 * j + 1][1]); w.w = cvt_pk_bf16(v[k][2 * j + 1][2], v[k][2 * j + 1][3]); *(u32x4*)(o + 512 * j) = w; }
            if (lane == 0) *(f32x4*)(rowss + (size_t)(r + k * NGW) * 4) = (f32x4){ss, 0.f, 0.f, 0.f};
        }
    }
}

__device__ __forceinline__ void attn_phase(LAS unsigned char* lds, const bf16_t* QK, const bf16_t* VT, bf16_t* O, const float* sinks, int G, int bid) {
    constexpr int LDK = 72, LDV = 280;
    LAS bf16_t* Ks = (LAS bf16_t*)lds;
    LAS bf16_t* Vt = Ks + 272 * LDK;
    int tid = threadIdx.x; asm volatile("" : "+v"(tid));
    const int lane = tid & 63, w = tid >> 6, fr = lane & 15, fq = lane >> 4;
    const float L2E = 1.4426950408889634f;
    unsigned zu = 0u; asm volatile("" : "+v"(zu));
    u32x4 kreg[4], vreg[4];
#define AT_LOAD(un) do { const int nb_ = (un) & 31, g_ = ((un) >> 5) & 3, b_ = (un) >> 7, seq0_ = b_ * SEQ, blk0_ = nb_ * 128; \
        _Pragma("unroll") for (int pass = 0; pass < 4; ++pass) { const int kj = pass * 64 + (tid >> 3), seg = tid & 7, pos = blk0_ - 128 + kj; \
            kreg[pass] = (u32x4){zu, zu, zu, zu}; if (pos >= 0) kreg[pass] = *(const u32x4*)(QK + (size_t)(seq0_ + pos) * QKD + 1024 + g_ * 64 + seg * 8); } \
        _Pragma("unroll") for (int pass = 0; pass < 4; ++pass) { const int d = pass * 16 + (tid >> 5), seg = tid & 31, pos = blk0_ - 128 + seg * 8; \
            vreg[pass] = (u32x4){zu, zu, zu, zu}; if (pos >= 0) vreg[pass] = *(const u32x4*)(VT + (size_t)(g_ * 64 + d) * MTOK + seq0_ + pos); } } while (0)
    if (bid < BATCH * 4 * 32) AT_LOAD(bid);
    for (int unit = bid; unit < BATCH * 4 * 32; unit += G) {
        const int nb = unit & 31, g = (unit >> 5) & 3, b = unit >> 7;
        const int seq0 = b * SEQ, blk0 = nb * 128;
#pragma unroll
        for (int pass = 0; pass < 4; ++pass) *(LAS u32x4*)(Ks + (pass * 64 + (tid >> 3)) * LDK + (tid & 7) * 8) = kreg[pass];
        if (tid < 128) *(LAS u32x4*)(Ks + (256 + (tid >> 3)) * LDK + (tid & 7) * 8) = (u32x4){zu, zu, zu, zu};
#pragma unroll
        for (int pass = 0; pass < 4; ++pass) *(LAS u32x4*)(Vt + (pass * 16 + (tid >> 5)) * LDV + (tid & 31) * 8) = vreg[pass];
        if (tid < 128) *(LAS u32x4*)(Vt + (tid >> 1) * LDV + 256 + (tid & 1) * 8) = (u32x4){zu, zu, zu, zu};
        const int r = w >> 1, half = w & 1, h = g * 4 + r;
        const bf16_t* qbase = QK + (size_t)(seq0 + blk0 + 64 * half + fr) * QKD + h * 64 + 8 * fq;
        bf16x8 qn[2];
#pragma unroll
        for (int kk = 0; kk < 2; ++kk) qn[kk] = *(const bf16x8*)(qbase + 32 * kk);
        if (unit + G < BATCH * 4 * 32) AT_LOAD(unit + G);
        __syncthreads();
        const float slope2 = __builtin_amdgcn_exp2f(-0.5f * (float)(h + 1)) * L2E, sink2 = sinks[h] * L2E;
        const float c2 = 0.125f * L2E;
#pragma unroll 1
        for (int qt = 0; qt < 4; ++qt) {
            const int j0 = 4 * half + qt, q0 = 16 * j0;
            const size_t tokq = (size_t)(seq0 + blk0 + q0 + fr);
            bf16x8 qf[2]; qf[0] = qn[0]; qf[1] = qn[1];
            if (qt < 3) {
#pragma unroll
                for (int kk = 0; kk < 2; ++kk) qn[kk] = *(const bf16x8*)(qbase + (size_t)(16 * (qt + 1)) * QKD + 32 * kk);
            }
            f32x4 S[10];
#pragma unroll
            for (int jj = 0; jj < 9; ++jj) {
                S[jj] = (f32x4){0.f, 0.f, 0.f, 0.f};
#pragma unroll
                for (int kk = 0; kk < 2; ++kk) { const bf16x8 kf = *(const LAS bf16x8*)(Ks + (16 * (j0 + jj) + fr) * LDK + 32 * kk + 8 * fq);
                    S[jj] = __builtin_amdgcn_mfma_f32_16x16x32_bf16(kf, qf[kk], S[jj], 0, 0, 0); }
            }
            float mx = sink2;
#pragma unroll
            for (int jj = 0; jj < 9; ++jj)
#pragma unroll
                for (int i = 0; i < 4; ++i) {
                    const int kjr = 16 * jj + 4 * fq + i;
                    const int dist = fr + 128 - kjr;
                    const bool valid = (dist >= 0) && (dist < 128) && (blk0 - 128 + q0 + kjr >= 0);
                    const float sv = valid ? (S[jj][i] * c2 - slope2 * (float)dist) : -INFINITY;
                    S[jj][i] = sv; mx = fmaxf(mx, sv);
                }
            mx = fmaxf(mx, __shfl_xor(mx, 16)); mx = fmaxf(mx, __shfl_xor(mx, 32));
            float sum = 0.f;
#pragma unroll
            for (int jj = 0; jj < 9; ++jj)
#pragma unroll
                for (int i = 0; i < 4; ++i) { const float p = __builtin_amdgcn_exp2f(S[jj][i] - mx); S[jj][i] = p; sum += p; }
            S[9] = (f32x4){0.f, 0.f, 0.f, 0.f};
            sum += __shfl_xor(sum, 16); sum += __shfl_xor(sum, 32);
            const float inv = 1.0f / (sum + __builtin_amdgcn_exp2f(sink2 - mx));
            f32x4 oa[4];
#pragma unroll
            for (int dt = 0; dt < 4; ++dt) oa[dt] = (f32x4){0.f, 0.f, 0.f, 0.f};
#pragma unroll
            for (int ks = 0; ks < 5; ++ks) {
                u32x4 pw; pw.x = cvt_pk_bf16(S[2 * ks][0], S[2 * ks][1]); pw.y = cvt_pk_bf16(S[2 * ks][2], S[2 * ks][3]);
                pw.z = cvt_pk_bf16(S[2 * ks + 1][0], S[2 * ks + 1][1]); pw.w = cvt_pk_bf16(S[2 * ks + 1][2], S[2 * ks + 1][3]);
                const bf16x8 pf = __builtin_bit_cast(bf16x8, pw);
#pragma unroll
                for (int dt = 0; dt < 4; ++dt) {
                    const LAS bf16_t* vp = Vt + (16 * dt + fr) * LDV + 16 * (j0 + 2 * ks) + 4 * fq;
                    const u32x2 lo = *(const LAS u32x2*)vp, hi = *(const LAS u32x2*)(vp + 16);
                    const u32x4 vv = (u32x4){lo.x, lo.y, hi.x, hi.y};
                    oa[dt] = __builtin_amdgcn_mfma_f32_16x16x32_bf16(__builtin_bit_cast(bf16x8, vv), pf, oa[dt], 0, 0, 0);
                }
            }
            bf16_t* op = O + tokq * DM + h * 64 + 16 * (fq & 1) + 8 * (fq >> 1);
#pragma unroll
            for (int dt = 0; dt < 4; dt += 2) {
                const unsigned ax = cvt_pk_bf16(oa[dt][0] * inv, oa[dt][1] * inv), ay = cvt_pk_bf16(oa[dt][2] * inv, oa[dt][3] * inv);
                const unsigned bx = cvt_pk_bf16(oa[dt + 1][0] * inv, oa[dt + 1][1] * inv), by = cvt_pk_bf16(oa[dt + 1][2] * inv, oa[dt + 1][3] * inv);
                const auto s0 = __builtin_amdgcn_permlane16_swap(ax, bx, false, false), s1 = __builtin_amdgcn_permlane16_swap(ay, by, false, false);
                *(u32x4*)(op + 16 * dt) = (u32x4){s0[0], s1[0], s0[1], s1[1]};
            }
        }
        __syncthreads();
    }
#undef AT_LOAD
}

__device__ __forceinline__ void spatial_phase(LAS unsigned char* lds, const bf16_t* VT, bf16_t* U, const bf16_t* Wsb, const float* psum, const float* psq,
                                              const float* lng, const float* lnb, const float* bs, int G, int bid) {
    constexpr int LDA = 136, NU = (MTOK / CHK) * NGRP;
    LAS bf16_t* As = (LAS bf16_t*)lds;
    LAS bf16_t* Bs = As + 2 * 128 * LDA;
    LAS float* tbl = (LAS float*)(Bs + 128 * LDA);
    LAS float* st = tbl + 512;
    LAS float* red = st + 256;
    int tid = threadIdx.x; asm volatile("" : "+v"(tid));
    const int lane = tid & 63, w = tid >> 6, fr = lane & 15, fq = lane >> 4;
    const int srow = tid >> 4, sseg = tid & 15, tt = tid & 127, part = tid >> 7;
    int unit = bid;
    if (unit >= NU) return;
    float sp[12], lgn[4], lbn[4], bsn = 0.f; u32x4 wraw[4], R[4], uvn[4], uvc[4];
#define SP_LOAD_SP(un) do { const int tok0_ = ((un) >> 3) * CHK; _Pragma("unroll") for (int k = 0; k < 6; ++k) { sp[k] = psum[(size_t)(part * 6 + k) * MTOK + tok0_ + tt]; sp[6 + k] = psq[(size_t)(part * 6 + k) * MTOK + tok0_ + tt]; } \
        if (tid < 128) bsn = bs[((un) & 7) * CHK + tid]; } while (0)
#define SP_LOAD_W(un) do { const int g_ = (un) & 7; _Pragma("unroll") for (int p = 0; p < 4; ++p) wraw[p] = *(const u32x4*)(Wsb + (size_t)(g_ * CHK + p * 32 + srow) * CHK + sseg * 8); } while (0)
#define SP_LOAD_R(un, db_) do { const int g_ = (un) & 7, tok0_ = ((un) >> 3) * CHK; _Pragma("unroll") for (int p = 0; p < 4; ++p) { const int f_ = g_ * GD + (db_) * 128 + p * 32 + srow; \
        R[p] = *(const u32x4*)(VT + (size_t)f_ * MTOK + tok0_ + sseg * 8); lgn[p] = lng[f_]; lbn[p] = lnb[f_]; } } while (0)
#define SP_LOAD_UV(un, db_) do { const int g_ = (un) & 7, tok0_ = ((un) >> 3) * CHK; _Pragma("unroll") for (int q = 0; q < 4; ++q) uvn[q] = *(const u32x4*)(U + (size_t)(tok0_ + 16 * (2 * q + (fq & 1)) + fr) * SH + g_ * GD + (db_) * 128 + 16 * w + 8 * (fq >> 1)); } while (0)
#define SP_WRITE_A(buf) do { _Pragma("unroll") for (int p = 0; p < 4; ++p) { float o_[8]; const float lg_ = lgn[p], lb_ = lbn[p]; \
        _Pragma("unroll") for (int e = 0; e < 4; ++e) { const unsigned wv_ = R[p][e]; const f32x4 m_ = *(const LAS f32x4*)(st + 2 * (sseg * 8 + 2 * e)); \
            o_[2 * e] = (bf_lo(wv_) - m_[0]) * m_[1] * lg_ + lb_; o_[2 * e + 1] = (bf_hi(wv_) - m_[2]) * m_[3] * lg_ + lb_; } \
        u32x4 pk_; pk_.x = cvt_pk_bf16(o_[0], o_[1]); pk_.y = cvt_pk_bf16(o_[2], o_[3]); pk_.z = cvt_pk_bf16(o_[4], o_[5]); pk_.w = cvt_pk_bf16(o_[6], o_[7]); \
        *(LAS u32x4*)(As + (buf) * 128 * LDA + (p * 32 + srow) * LDA + sseg * 8) = pk_; } } while (0)
    SP_LOAD_SP(unit); SP_LOAD_W(unit); SP_LOAD_R(unit, 0); SP_LOAD_UV(unit, 0);
    for (;;) {
        const int g = unit & 7, tok0 = (unit >> 3) * CHK;
        const bool has_next = unit + G < NU;
        { const float s6 = ((sp[0] + sp[1]) + (sp[2] + sp[3])) + (sp[4] + sp[5]), q6 = ((sp[6] + sp[7]) + (sp[8] + sp[9])) + (sp[10] + sp[11]);
          *(LAS f32x2*)(red + (part * 128 + tt) * 2) = (f32x2){s6, q6}; }
        __syncthreads();
        if (tid < 128) {
            const f32x2 a0 = *(const LAS f32x2*)(red + tid * 2), a1 = *(const LAS f32x2*)(red + (128 + tid) * 2), a2 = *(const LAS f32x2*)(red + (256 + tid) * 2), a3 = *(const LAS f32x2*)(red + (384 + tid) * 2);
            const float mean = ((a0.x + a1.x) + (a2.x + a3.x)) * (1.f / SH), var = fmaxf(((a0.y + a1.y) + (a2.y + a3.y)) * (1.f / SH) - mean * mean, 0.f);
            *(LAS f32x2*)(st + 2 * tid) = (f32x2){mean, __builtin_amdgcn_rsqf(var + EPS)};
            tbl[tid] = bsn;
        }
        __syncthreads();
#pragma unroll
        for (int p = 0; p < 4; ++p) *(LAS u32x4*)(Bs + (p * 32 + srow) * LDA + sseg * 8) = wraw[p];
        SP_WRITE_A(0);
#pragma unroll
        for (int q = 0; q < 4; ++q) uvc[q] = uvn[q];
        __syncthreads();
#pragma unroll
        for (int db = 0; db < 3; ++db) {
            const LAS bf16_t* Ab = As + (db & 1) * 128 * LDA;
            if (db < 2) { SP_LOAD_R(unit, db + 1); SP_LOAD_UV(unit, db + 1); }
            else if (has_next) { SP_LOAD_SP(unit + G); SP_LOAD_W(unit + G); SP_LOAD_R(unit + G, 0); SP_LOAD_UV(unit + G, 0); }
            const int fcol = g * GD + db * 128 + 16 * w + 4 * fq;
            f32x4 acc[8];
#pragma unroll
            for (int n = 0; n < 8; ++n) acc[n] = (f32x4){0.f, 0.f, 0.f, 0.f};
#pragma unroll
            for (int kk = 0; kk < 4; ++kk) {
                const bf16x8 a = *(const LAS bf16x8*)(Ab + (16 * w + fr) * LDA + 32 * kk + 8 * fq);
#pragma unroll
                for (int n = 0; n < 8; ++n) { const bf16x8 bb = *(const LAS bf16x8*)(Bs + (16 * n + fr) * LDA + 32 * kk + 8 * fq);
                    acc[n] = __builtin_amdgcn_mfma_f32_16x16x32_bf16(a, bb, acc[n], 0, 0, 0); }
            }
#pragma unroll
            for (int q = 0; q < 4; ++q) {
                const float bsA = tbl[32 * q + fr], bsB = tbl[32 * q + 16 + fr];
                const u32x4 L = uvc[q];
                const auto u0 = __builtin_amdgcn_permlane16_swap(L.x, L.z, false, false), u1 = __builtin_amdgcn_permlane16_swap(L.y, L.w, false, false);
                const unsigned pAx = cvt_pk_bf16((acc[2 * q][0] + bsA) * bf_lo(u0[0]), (acc[2 * q][1] + bsA) * bf_hi(u0[0])), pAy = cvt_pk_bf16((acc[2 * q][2] + bsA) * bf_lo(u1[0]), (acc[2 * q][3] + bsA) * bf_hi(u1[0]));
                const unsigned pBx = cvt_pk_bf16((acc[2 * q + 1][0] + bsB) * bf_lo(u0[1]), (acc[2 * q + 1][1] + bsB) * bf_hi(u0[1])), pBy = cvt_pk_bf16((acc[2 * q + 1][2] + bsB) * bf_lo(u1[1]), (acc[2 * q + 1][3] + bsB) * bf_hi(u1[1]));
                const auto s0 = __builtin_amdgcn_permlane16_swap(pAx, pBx, false, false), s1 = __builtin_amdgcn_permlane16_swap(pAy, pBy, false, false);
                *(u32x4*)(U + (size_t)(tok0 + 16 * (2 * q + (fq & 1)) + fr) * SH + g * GD + db * 128 + 16 * w + 8 * (fq >> 1)) = (u32x4){s0[0], s1[0], s0[1], s1[1]};
            }
            if (db < 2) {
                SP_WRITE_A((db + 1) & 1);
#pragma unroll
                for (int q = 0; q < 4; ++q) uvc[q] = uvn[q];
                __syncthreads();
            }
        }
        if (!has_next) break;
        unit += G;
    }
#undef SP_LOAD_SP
#undef SP_LOAD_W
#undef SP_LOAD_R
#undef SP_LOAD_UV
#undef SP_WRITE_A
}

#define XB_TMO      128
#define XB_XCNT(j)  (256  + 64 * (j))
#define XB_XSUB(j)  (1280 + 64 * (j))
#define XB_XGEN(j)  (2304 + 64 * (j))
#define XB_TOP      3328
#define XB_TOPGEN   3392
#define XCD_BAR_WORDS 3456
#define XB_SPIN_CAP (1u << 22)
__device__ __forceinline__ unsigned xb_ld(unsigned* p)              { return __hip_atomic_load(p, __ATOMIC_RELAXED, __HIP_MEMORY_SCOPE_AGENT); }
__device__ __forceinline__ unsigned xb_add(unsigned* p, unsigned v) { return __hip_atomic_fetch_add(p, v, __ATOMIC_RELAXED, __HIP_MEMORY_SCOPE_AGENT); }
__device__ __forceinline__ unsigned xb_xcc_id() { return (unsigned)__builtin_amdgcn_s_getreg((3 << 11) | 20) & 0xFu; }
#define XB_SPIN(cond, bar) do { unsigned _sp = 0; while (cond) { __builtin_amdgcn_s_sleep(1); \
    if ((++_sp & 255u) == 0u) { if (xb_ld(&(bar)[XB_TMO])) break; if (_sp > XB_SPIN_CAP) { atomicAdd(&(bar)[XB_TMO], 1u); break; } } } } while (0)
struct XcdBarrier { unsigned* bar; unsigned x; volatile LAS unsigned* st; };
__device__ __forceinline__ XcdBarrier xcd_barrier_post(unsigned* bar, volatile LAS unsigned* st) {
    XcdBarrier b; b.bar = bar; b.x = xb_xcc_id(); b.st = st;
    if (threadIdx.x == 0) (void)xb_add(&bar[XB_XCNT(b.x)], 1u);
    return b;
}
__device__ __forceinline__ void xcd_barrier_complete(unsigned* bar, unsigned x, unsigned& nloc, unsigned& nx) {
    const unsigned G = gridDim.x * gridDim.y * gridDim.z;
    unsigned sum, cnt, mine, sp = 0u;
    for (;;) {
        sum = 0u; cnt = 0u; mine = 0u;
#pragma unroll
        for (unsigned j = 0; j < 16; ++j) { const unsigned c = xb_ld(&bar[XB_XCNT(j)]); sum += c; cnt += (c > 0u) ? 1u : 0u; mine = (j == x) ? c : mine; }
        if (sum == G) break;
        __builtin_amdgcn_s_sleep(1);
        if ((++sp & 255u) == 0u) { if (xb_ld(&bar[XB_TMO])) break; if (sp > XB_SPIN_CAP) { atomicAdd(&bar[XB_TMO], 1u); break; } }
    }
    nloc = mine > 0u ? mine : 1u; nx = cnt > 0u ? cnt : 1u;
}
__device__ __forceinline__ void xcd_barrier(const XcdBarrier& b) {
    asm volatile("s_waitcnt vmcnt(0)" ::: "memory");
    __syncthreads();
    if (threadIdx.x == 0) {
        unsigned* bar = b.bar;
        __builtin_amdgcn_s_waitcnt(0);
        unsigned nloc = b.st[0], nx = b.st[1];
        if (nloc == 0u) { xcd_barrier_complete(bar, b.x, nloc, nx); b.st[0] = nloc; b.st[1] = nx; }
        const unsigned old = xb_add(&bar[XB_XSUB(b.x)], 1u);
        const unsigned gen = old / nloc;
        if (old + 1u == (gen + 1u) * nloc) {
            __builtin_amdgcn_fence(__ATOMIC_RELEASE, "agent");
            asm volatile("s_waitcnt vmcnt(0)" ::: "memory");
            const unsigned og = xb_add(&bar[XB_TOP], 1u);
            const unsigned tg = og / nx;
            if (og + 1u == (tg + 1u) * nx) xb_add(&bar[XB_TOPGEN], 1u);
            else XB_SPIN(xb_ld(&bar[XB_TOPGEN]) == tg, bar);
            __builtin_amdgcn_fence(__ATOMIC_ACQUIRE, "agent");
            xb_add(&bar[XB_XGEN(b.x)], 1u);
            asm volatile("s_waitcnt vmcnt(0)" ::: "memory");
        } else {
            XB_SPIN(xb_ld(&bar[XB_XGEN(b.x)]) == gen, bar);
            __builtin_amdgcn_fence(__ATOMIC_ACQUIRE, "agent");
            asm volatile("s_waitcnt vmcnt(0)" ::: "memory");
        }
    }
    __syncthreads();
}

constexpr int LDS_RING = 131072, LDS_X = LDS_RING, LDS_BYTES = LDS_RING + 16384;

#define PHASE_IDS() int tid_ = threadIdx.x; asm volatile("" : "+v"(tid_)); const int lane = tid_ & 63, wave = __builtin_amdgcn_readfirstlane(tid_ >> 6); \
    const int gw = bid * NWAVES + wave, NGW = G * NWAVES; LAS float* scr = (LAS float*)(lds + wave * 16384)

__global__ void __launch_bounds__(NTHREADS, 2) fwd_megakernel(Params Pk) {
    extern __shared__ __attribute__((aligned(16))) unsigned char lds_raw[];
    cg::grid_group grid = cg::this_grid();
    LAS unsigned char* lds = (LAS unsigned char*)lds_raw;
    const int G = gridDim.x, bid = blockIdx.x;
#define P (*(const Params*)__builtin_amdgcn_kernarg_segment_ptr())
    volatile LAS unsigned* MISC = (volatile LAS unsigned*)(lds + LDS_X + 4096);
    if (threadIdx.x < 2) MISC[threadIdx.x] = 0u;
    __syncthreads();
    (void)xcd_barrier_post((unsigned*)P.ws, MISC);
#define GRID_BAR() do { XcdBarrier xb_; xb_.bar = (unsigned*)P.ws; xb_.x = xb_xcc_id(); xb_.st = (volatile LAS unsigned*)(lds + LDS_X + 4096); xcd_barrier(xb_); } while (0)
    {
        PHASE_IDS();
        convert_mixer(P, 0, scr, gw, NGW, lane);
        xb0_phase(P.in[0], (bf16_t*)(P.ws + WS_XN), (float*)(P.ws + WS_ROWSS), gw, NGW, lane);
        { u32x4* sl = (u32x4*)(P.ws + WS_SLOT);
          for (int i = gw * 64 + lane; i < (1 << 20) / 16; i += NGW * 64) sl[i] = (u32x4){0u, 0u, 0u, 0u}; }
    }
    grid.sync();

    for (int hl = 0; hl < 2 * DEPTH; ++hl) {
        const int L = hl >> 1, j = L >> 1;
        const bool attn = (L & 1) == 0;
        if ((hl & 1) == 0) {
            {
                PHASE_IDS();
                convert_ffn(P, L, scr, gw, NGW, lane);
                __syncthreads();
            }
            {
                unsigned char* ws = P.ws;
                const bf16_t* wv = (const bf16_t*)(ws + WS_WMIX + WM_A) + (size_t)(attn ? QKD : SH) * DM;
                pg8::Gemm g1{(const bf16_t*)(ws + WS_XN), (const bf16_t*)(ws + WS_WMIX + WM_A), DM, wv, (const bf16_t*)(ws + WS_XN)};
                pg8::Order S; S.init(MTOK / 256, attn ? QKD / 256 : SH / 256, G, bid, 0, attn ? KVD / 256 : SH / 256, MTOK / 256);
                EpiG1 E{attn ? 1 : 0, j};
                pg8::gemm_phase(lds, g1, S, E);
            }
            GRID_BAR();
            if (attn) {
                unsigned char* ws = P.ws;
                attn_phase(lds, (const bf16_t*)(ws + WS_BIG), (const bf16_t*)(ws + WS_BIG + 80 * MiB), (bf16_t*)(ws + WS_BIG + 96 * MiB), P.in[3] + j * NH, G, bid);
            } else {
                unsigned char* ws = P.ws;
                spatial_phase(lds, (const bf16_t*)(ws + WS_BIG + 192 * MiB), (bf16_t*)(ws + WS_BIG), (const bf16_t*)(ws + WS_WMIX + WM_S), (const float*)(ws + WS_PSUM), (const float*)(ws + WS_PSQ),
                              P.in[7] + (size_t)j * SH, P.in[8] + (size_t)j * SH, P.in[10] + (size_t)j * NGRP * CHK, G, bid);
            }
            GRID_BAR();
        } else {
            if (L + 1 < DEPTH) {
                PHASE_IDS();
                convert_mixer(P, L + 1, scr, gw, NGW, lane);
                __syncthreads();
            }
            unsigned char* ws = P.ws;
            pg8::Gemm g1{(const bf16_t*)(ws + WS_XN), (const bf16_t*)(ws + WS_WFFN + WF_A), DM, nullptr, nullptr};
            pg8::Order S; S.init(MTOK / 256, 2 * DFF / 256, G, bid, 0);
            EpiConv E{L, (LAS float*)(lds + LDS_X)};
            pg8::gemm_phase(lds, g1, S, E);
            GRID_BAR();
        }
        {
            unsigned char* ws = P.ws;
            pg8::Gemm gy;
            if ((hl & 1) == 0) {
                if (attn) gy = pg8::Gemm{(const bf16_t*)(ws + WS_BIG + 96 * MiB), (const bf16_t*)(ws + WS_WMIX + WM_B), DM, nullptr, nullptr};
                else gy = pg8::Gemm{(const bf16_t*)(ws + WS_BIG), (const bf16_t*)(ws + WS_WMIX + WM_B), SH, nullptr, nullptr};
            } else gy = pg8::Gemm{(const bf16_t*)(ws + WS_BIG), (const bf16_t*)(ws + WS_WFFN + WF_B), DFF, nullptr, nullptr};
            pg8::Order S; S.init(MTOK / 256, DM / 256, G, bid, 0);
            if (hl & 1) {
                int tid_ = threadIdx.x; asm volatile("" : "+v"(tid_));
                pg8::Unit fu;
                for (int i = 0; S.next(i, fu); ++i) ffn_fixup(fu.pm, L, tid_);
                asm volatile("s_waitcnt vmcnt(0)" ::: "memory"); __syncthreads();
            }
            EpiResid E{hl, (LAS float*)(lds + LDS_X + 8192), (LAS float*)(lds + LDS_X + 12288)};
            pg8::gemm_phase(lds, gy, S, E);
        }
        if (hl + 1 < 2 * DEPTH) GRID_BAR();
    }
#undef P
#undef GRID_BAR
}

extern "C" void kernel_launch(void* const* d_in, const int* in_sizes, int n_in, void* d_out, int out_size, void* d_ws, size_t ws_size, hipStream_t stream) {
    static int grid = 0;
    if (grid == 0) {
        if (n_in != 20 || in_sizes[0] != MTOK * DM || out_size != MTOK * DM || ws_size < WS_END) {
            fprintf(stderr, "kernel_launch: unexpected shapes (n_in %d, in0 %d, out %d, ws %zu, need %zu); nothing launched\n", n_in, n_in > 0 ? in_sizes[0] : -1, out_size, ws_size, (size_t)WS_END);
            grid = -1; return; }
        int dev = 0, cus = 0, per_cu = 0;
        hipGetDevice(&dev);
        hipDeviceGetAttribute(&cus, hipDeviceAttributeMultiprocessorCount, dev);
        hipFuncSetAttribute((const void*)fwd_megakernel, hipFuncAttributeMaxDynamicSharedMemorySize, LDS_BYTES);
        hipOccupancyMaxActiveBlocksPerMultiprocessor(&per_cu, (const void*)fwd_megakernel, NTHREADS, LDS_BYTES);
        if (per_cu < 1) per_cu = 1;
        (void)hipGetLastError();
        grid = cus;
    }
    if (grid < 0) return;
    if (hipMemsetAsync(d_ws, 0, 16384, stream) != hipSuccess) { fprintf(stderr, "kernel_launch: memset failed\n"); return; }
    Params p{};
    for (int i = 0; i < 20; ++i) p.in[i] = (const float*)d_in[i];
    p.out = (float*)d_out; p.ws = (unsigned char*)d_ws;
    void* args[] = {&p};
    hipError_t e = hipLaunchCooperativeKernel((const void*)fwd_megakernel, dim3(grid), dim3(NTHREADS), args, LDS_BYTES, stream);
    if (e != hipSuccess) fprintf(stderr, "cooperative launch failed: %s (grid %d)\n", hipGetErrorString(e), grid);
}
```

```cpp
#include <hip/hip_runtime.h>
#include <hip/hip_cooperative_groups.h>
#include <cstdio>
#include <cstdint>
namespace cg = cooperative_groups;

#define LAS __attribute__((address_space(3)))
typedef unsigned short bf16_t;
typedef short bf16x8 __attribute__((ext_vector_type(8)));
typedef float f32x4 __attribute__((ext_vector_type(4)));
typedef float f32x2 __attribute__((ext_vector_type(2)));
typedef unsigned u32x4 __attribute__((ext_vector_type(4)));
typedef unsigned u32x2 __attribute__((ext_vector_type(2)));

constexpr int DM = 1024, BATCH = 8, SEQ = 4096, MTOK = BATCH * SEQ, DEPTH = 4;
constexpr int QKV = 1536, QKD = 1280, KVD = 256, NH = 16;
constexpr int SH = 3072, NGRP = 8, GD = 384, CHK = 128;
constexpr int DFF = 2816;
constexpr float EPS = 1e-6f;
constexpr int NWAVES = 8, NTHREADS = 512;
constexpr int FFN_TPS = 17;

constexpr size_t MiB = 1u << 20;
constexpr size_t WS_PSUM = 1 * MiB;
constexpr size_t WS_PSQ = 4 * MiB;
constexpr size_t WS_CNT = 64 * 1024;
constexpr size_t WS_ROWSS = 7 * MiB;
constexpr size_t WS_SLOT = 26 * MiB + 512 * 1024;
constexpr size_t WS_WMIX = 8 * MiB;
constexpr size_t WS_WFFN = 28 * MiB;
constexpr size_t WS_XN = 48 * MiB;
constexpr size_t WS_BIG = 114 * MiB;
constexpr size_t WS_SBG0 = WS_BIG + 180 * MiB, WS_SBU0 = WS_BIG + 183 * MiB, WS_SB1 = WS_BIG + 186 * MiB;
constexpr size_t WS_END = WS_BIG + 384 * MiB;
constexpr size_t WM_A = 0;
constexpr size_t WM_B = 12 * MiB;
constexpr size_t WM_S = 18 * MiB;
constexpr size_t WF_A = 0;
constexpr size_t WF_B = 11 * MiB;

__device__ __forceinline__ unsigned cvt_pk_bf16(float lo, float hi) { unsigned r; asm volatile("v_cvt_pk_bf16_f32 %0, %1, %2" : "=v"(r) : "v"(lo), "v"(hi)); return r; }
__device__ __forceinline__ float bf_lo(unsigned w) { return __uint_as_float(w << 16); }
__device__ __forceinline__ float bf_hi(unsigned w) { return __uint_as_float(w & 0xffff0000u); }
__device__ __forceinline__ float gelu_tanh(float x) {
    const float t = x * (1.0f + 0.044715f * x * x) * (-2.0f * 0.7978845608028654f * 1.4426950408889634f);
    const float e = __builtin_amdgcn_exp2f(t);
    return x * __builtin_amdgcn_rcpf(1.0f + e);
}
__device__ __forceinline__ f32x2 gelu2(f32x2 x) {
    const float KK = -2.0f * 0.7978845608028654f * 1.4426950408889634f;
    const f32x2 p = (x * x) * (0.044715f * KK) + KK, t = x * p;
    f32x2 e; e.x = __builtin_amdgcn_exp2f(t.x); e.y = __builtin_amdgcn_exp2f(t.y);
    const f32x2 d = e + 1.0f;
    f32x2 r; r.x = __builtin_amdgcn_rcpf(d.x); r.y = __builtin_amdgcn_rcpf(d.y);
    return x * r;
}
__device__ __forceinline__ f32x4 gelu4(f32x4 v) { const f32x2 a = gelu2((f32x2){v[0], v[1]}), b = gelu2((f32x2){v[2], v[3]}); return (f32x4){a.x, a.y, b.x, b.y}; }
template <int CTRL> __device__ __forceinline__ float dpp_f(float v) { return __int_as_float(__builtin_amdgcn_update_dpp(0, __float_as_int(v), CTRL, 0xf, 0xf, true)); }
__device__ __forceinline__ float row16_sum(float v) { v += dpp_f<0xB1>(v); v += dpp_f<0x4E>(v); v += dpp_f<0x124>(v); v += dpp_f<0x128>(v); return v; }
__device__ __forceinline__ float wave_sum(float v) {
#pragma unroll
    for (int o = 1; o < 64; o <<= 1) v += __shfl_xor(v, o);
    return v;
}

namespace pg8 {
constexpr int BM = 256, BK = 64, HALF = 128, HTB = HALF * BK * 2, STAGE_BYTES = 8 * HTB, NXCD = 8, WGM = 8;
__host__ __device__ __forceinline__ int lds_byte(int r, int c) { const int st = (r >> 4) * 2 + (c >> 5), rr = r & 15, cc = c & 31, ob = rr * 64 + cc * 2; return st * 1024 + (ob ^ (((ob >> 9) & 1) << 5)); }
__host__ __device__ __forceinline__ void stage_rc(int b, int& R, int& C) { const int st = b / 1024, sb = b % 1024, swz = sb ^ (((sb >> 9) & 1) << 5); R = (st >> 1) * 16 + swz / 64; C = (st & 1) * 32 + (swz % 64) / 2; }
__host__ __device__ __forceinline__ int perm32(int rho) { const int n = rho >> 4, i = rho & 15; return 8 * (i >> 2) + 4 * n + (i & 3); }

struct Unit { int pm, pn, arow, brow, kind; };
struct Gemm { const bf16_t* A; const bf16_t* Bt; int K; const bf16_t* A1; const bf16_t* Bt1; };

struct Order {
    int nM, nN, nwg, G, c, ovl, nM1, nN1, nwg1;
    __device__ __forceinline__ void init(int nM_, int nN_, int G_, int c_, int ovl_, int nM1_ = 0, int nN1_ = 0) { nM = nM_; nN = nN_; nwg = nM * nN; G = G_; c = c_; ovl = ovl_; nM1 = nM1_; nN1 = nN1_; nwg1 = nM1 * nN1; }
    __device__ __forceinline__ static void deal(int wgid, int nwg_, int nM_, int nN_, int& pm, int& pn) {
        { const int q = nwg_ / NXCD, r = nwg_ % NXCD, xcd = wgid % NXCD, off = wgid / NXCD; wgid = (xcd < r ? xcd * (q + 1) : r * (q + 1) + (xcd - r) * q) + off; }
        const int nig = WGM * nN_, gid = wgid / nig, fm = gid * WGM, gsz = (nM_ - fm) < WGM ? (nM_ - fm) : WGM;
        pm = fm + ((wgid % nig) % gsz); pn = (wgid % nig) / gsz;
    }
    __device__ __forceinline__ bool next(int i, Unit& u) const {
        const long L = (long)i * G + c; if (L >= nwg + nwg1) return false;
        if (L < nwg) { deal((int)L, nwg, nM, nN, u.pm, u.pn); u.kind = 0; }
        else { deal((int)L - nwg, nwg1, nM1, nN1, u.pm, u.pn); u.kind = 1; }
        u.arow = u.pm * BM;
        u.brow = u.pn * BM;
        return true;
    }
};

template <class Epi>
__device__ __forceinline__ void gemm_phase(LAS unsigned char* lds, const Gemm g, const Order& S, Epi& E) {
    int tid = threadIdx.x; asm volatile("" : "+v"(tid));
    const int wid = __builtin_amdgcn_readfirstlane(tid >> 6), lane = tid & 63, wr = wid >> 2, wc = wid & 3, fr = lane & 15, fq = lane >> 4;
    const int K = g.K, nt = K / BK;
    unsigned voffA[2], voffB[2];
#pragma unroll
    for (int i = 0; i < 2; ++i) { int R, C; stage_rc(tid * 16 + i * 8192, R, C); const int Rb = (R & ~31) + perm32(R & 31);
        voffA[i] = (unsigned)(R * K + C) * 2u; voffB[i] = (unsigned)(Rb * K + C) * 2u; }
    const size_t kstep = (size_t)(BK * 2);
    const size_t hstep = (size_t)HALF * K * 2;
    const long rowb = (long)K * 2;
    const unsigned ldsw = (unsigned)wid * 1024u;
    const int aoff = lds_byte(wr * 64 + fr, fq * 8), boff = lds_byte(wc * 32 + fr, fq * 8);
#define PG8_SA(b, h) (((b) * 2 + (h)) * HTB)
#define PG8_SB(b, h) ((4 + (b) * 2 + (h)) * HTB)
#define PG8_STAGE(bufoff, gbase, voff) do { _Pragma("unroll") for (int _i = 0; _i < 2; ++_i) \
        __builtin_amdgcn_global_load_lds((const unsigned*)((const char*)(gbase) + (voff)[_i]), (LAS unsigned*)(lds + (bufoff) + ldsw + _i * 8192), 16, 0, 0); } while (0)
#define PG8_LDA(dst, b, h) do { _Pragma("unroll") for (int m = 0; m < 4; ++m) _Pragma("unroll") for (int k = 0; k < 2; ++k) dst[m][k] = *(const LAS bf16x8*)(lds + PG8_SA(b, h) + aoff + m * 2048 + k * 1024); } while (0)
#define PG8_LDB(dst, b, h) do { _Pragma("unroll") for (int n = 0; n < 2; ++n) _Pragma("unroll") for (int k = 0; k < 2; ++k) dst[n][k] = *(const LAS bf16x8*)(lds + PG8_SB(b, h) + boff + n * 2048 + k * 1024); } while (0)
#define PG8_MMA(ai, bj, At, Bt) do { __builtin_amdgcn_s_setprio(1); _Pragma("unroll") for (int m = 0; m < 4; ++m) _Pragma("unroll") for (int n = 0; n < 2; ++n) _Pragma("unroll") for (int k = 0; k < 2; ++k) \
        acc[ai][bj][m][n] = __builtin_amdgcn_mfma_f32_16x16x32_bf16(Bt[n][k], At[m][k], acc[ai][bj][m][n], 0, 0, 0); __builtin_amdgcn_s_setprio(0); } while (0)
#define PG8_WAIT_V(n) asm volatile("s_waitcnt vmcnt(" #n ")" ::: "memory")
#define PG8_WAIT_L(n) asm volatile("s_waitcnt lgkmcnt(" #n ")" ::: "memory")
#define PG8_BAR __builtin_amdgcn_s_barrier()
#define PG8_SCHED __builtin_amdgcn_sched_barrier(0)
    Unit cur, nxt; int ui = 0;
    if (!S.next(0, cur)) return;
    float zf = 0.f; asm volatile("" : "+v"(zf));
    f32x4 acc[2][2][4][2];
#pragma unroll
    for (int a = 0; a < 2; ++a)
#pragma unroll
        for (int b = 0; b < 2; ++b)
#pragma unroll
            for (int m = 0; m < 4; ++m)
#pragma unroll
                for (int n = 0; n < 2; ++n) acc[a][b][m][n] = (f32x4){zf, zf, zf, zf};
    bf16x8 At[4][2], B0[2][2], B1[2][2];
    const char* cA = (const char*)(cur.kind ? g.A1 : g.A) + (long)cur.arow * rowb; const char* cB = (const char*)(cur.kind ? g.Bt1 : g.Bt) + (long)cur.brow * rowb;
    PG8_STAGE(PG8_SB(0, 0), cB, voffB); PG8_STAGE(PG8_SB(0, 1), cB + hstep, voffB); PG8_STAGE(PG8_SA(0, 0), cA, voffA); PG8_STAGE(PG8_SA(0, 1), cA + hstep, voffA);
    if (wr == 1) PG8_BAR;
    PG8_WAIT_V(2); PG8_BAR;
    PG8_STAGE(PG8_SB(1, 0), cB + kstep, voffB); PG8_STAGE(PG8_SA(1, 0), cA + kstep, voffA); PG8_STAGE(PG8_SB(1, 1), cB + hstep + kstep, voffB);
    PG8_WAIT_V(6); PG8_BAR;
    for (;;) {
        const bool has_next = S.next(ui + 1, nxt);
        const char* nA = has_next ? (const char*)(nxt.kind ? g.A1 : g.A) + (long)nxt.arow * rowb : cA; const char* nB = has_next ? (const char*)(nxt.kind ? g.Bt1 : g.Bt) + (long)nxt.brow * rowb : cB;
        for (int t = 0; t < nt; t += 2) {
            const bool last = (t == nt - 2);
            const char* a1 = cA + (size_t)(t + 1) * kstep;
            const char* a2 = last ? nA : cA + (size_t)(t + 2) * kstep; const char* b2 = last ? nB : cB + (size_t)(t + 2) * kstep;
            const char* a3 = a2 + kstep; const char* b3 = b2 + kstep;
            PG8_LDB(B0, 0, 0); PG8_LDB(B1, 0, 1); PG8_SCHED; PG8_LDA(At, 0, 0); PG8_STAGE(PG8_SA(1, 1), a1 + hstep, voffA);
            PG8_WAIT_V(8); PG8_WAIT_L(0); PG8_BAR; PG8_MMA(0, 0, At, B0); PG8_MMA(0, 1, At, B1); PG8_BAR; PG8_SCHED;
            PG8_LDA(At, 0, 1); PG8_STAGE(PG8_SB(0, 0), b2, voffB); PG8_STAGE(PG8_SB(0, 1), b2 + hstep, voffB); PG8_STAGE(PG8_SA(0, 0), a2, voffA);
            PG8_WAIT_V(8); PG8_WAIT_L(0); PG8_BAR; PG8_MMA(1, 0, At, B0); PG8_MMA(1, 1, At, B1); PG8_BAR; PG8_SCHED;
            PG8_LDB(B0, 1, 0); PG8_LDB(B1, 1, 1); PG8_SCHED; PG8_LDA(At, 1, 0); PG8_STAGE(PG8_SA(0, 1), a2 + hstep, voffA);
            PG8_WAIT_V(8); PG8_WAIT_L(0); PG8_BAR; PG8_MMA(0, 0, At, B0); PG8_MMA(0, 1, At, B1); PG8_BAR; PG8_SCHED;
            PG8_LDA(At, 1, 1); PG8_STAGE(PG8_SB(1, 0), b3, voffB); PG8_STAGE(PG8_SB(1, 1), b3 + hstep, voffB); PG8_STAGE(PG8_SA(1, 0), a3, voffA);
            PG8_WAIT_V(8); PG8_WAIT_L(0); PG8_BAR; PG8_MMA(1, 0, At, B0); PG8_MMA(1, 1, At, B1); PG8_BAR; PG8_SCHED;
        }
        if (wr == 0) PG8_BAR;
        E(acc, cur, wr, wc, fr, fq, lane);
        if (!has_next) break;
#pragma unroll
        for (int a = 0; a < 2; ++a)
#pragma unroll
            for (int b = 0; b < 2; ++b)
#pragma unroll
                for (int m = 0; m < 4; ++m)
#pragma unroll
                    for (int n = 0; n < 2; ++n) acc[a][b][m][n] = (f32x4){zf, zf, zf, zf};
        cur = nxt; cA = nA; cB = nB; ++ui;
        if (wr == 1) PG8_BAR;
    }
    PG8_WAIT_V(0);
    PG8_BAR;
#undef PG8_SA
#undef PG8_SB
#undef PG8_STAGE
#undef PG8_LDA
#undef PG8_LDB
#undef PG8_MMA
#undef PG8_WAIT_V
#undef PG8_WAIT_L
#undef PG8_BAR
#undef PG8_SCHED
}
}

struct Params { const float* in[20]; float* out; unsigned char* ws; };
#define KP (*(const Params*)__builtin_amdgcn_kernarg_segment_ptr())
__device__ __forceinline__ float rstd_of(const float* rowss, int row) { const f32x4 p = *(const f32x4*)(rowss + (size_t)row * 4); return __builtin_amdgcn_rsqf(((p[0] + p[1]) + (p[2] + p[3])) * (1.f / DM) + EPS); }
struct EpiStore {
    int attn, j;
    __device__ __forceinline__ void operator()(f32x4 (&acc)[2][2][4][2], const pg8::Unit& u, int wr, int wc, int fr, int fq, int lane) const {
        unsigned char* ws = KP.ws;
        bf16_t* O = (bf16_t*)(ws + WS_BIG); const long ldc = attn ? (long)QKD : (long)SH; const float* cbias = attn ? KP.in[2] + (size_t)j * QKV : nullptr; const int act = attn ? 0 : 1;
        const float* rowss = (const float*)(ws + WS_ROWSS);
        const int row0 = u.pm * 256 + wr * 64 + fr, col0 = u.pn * 256 + wc * 32 + 8 * fq;
        float rs[2][4];
#pragma unroll
        for (int ai = 0; ai < 2; ++ai)
#pragma unroll
            for (int m = 0; m < 4; ++m) rs[ai][m] = rstd_of(rowss, row0 + ai * 128 + m * 16);
        f32x4 bv[2][2];
#pragma unroll
        for (int bj = 0; bj < 2; ++bj)
#pragma unroll
            for (int n = 0; n < 2; ++n) bv[bj][n] = cbias ? *(const f32x4*)(cbias + col0 + bj * 128 + 4 * n) : (f32x4){0.f, 0.f, 0.f, 0.f};
#pragma unroll
        for (int ai = 0; ai < 2; ++ai)
#pragma unroll
            for (int m = 0; m < 4; ++m) { bf16_t* rowp = O + (size_t)(row0 + ai * 128 + m * 16) * ldc + col0;
#pragma unroll
                for (int bj = 0; bj < 2; ++bj) { f32x4 v0 = acc[ai][bj][m][0] * rs[ai][m] + bv[bj][0], v1 = acc[ai][bj][m][1] * rs[ai][m] + bv[bj][1];
                    if (act) { v0 = gelu4(v0); v1 = gelu4(v1); }
                    u32x4 w; w.x = cvt_pk_bf16(v0[0], v0[1]); w.y = cvt_pk_bf16(v0[2], v0[3]); w.z = cvt_pk_bf16(v1[0], v1[1]); w.w = cvt_pk_bf16(v1[2], v1[3]);
                    *(u32x4*)(rowp + bj * 128) = w; } }
    }
};
struct EpiVT {
    int attn, j;
    __device__ __forceinline__ void operator()(f32x4 (&acc)[2][2][4][2], const pg8::Unit& u, int wr, int wc, int fr, int fq, int lane) const {
        unsigned char* ws = KP.ws;
        bf16_t* O = (bf16_t*)(ws + WS_BIG + (attn ? 80 : 192) * MiB); const float* rbias = attn ? KP.in[2] + (size_t)j * QKV + QKD : nullptr; const int act = attn ? 0 : 1;
        float* psum = attn ? nullptr : (float*)(ws + WS_PSUM); float* psq = attn ? nullptr : (float*)(ws + WS_PSQ); const float* rowss = (const float*)(ws + WS_ROWSS);
        const int row0 = u.pm * 256 + wr * 64 + fr, col0 = u.pn * 256 + wc * 32 + 8 * fq;
#pragma unroll
        for (int bj = 0; bj < 2; ++bj) {
            f32x4 c0, c1v;
#pragma unroll
            for (int i = 0; i < 4; ++i) { c0[i] = rstd_of(rowss, col0 + bj * 128 + i); c1v[i] = rstd_of(rowss, col0 + bj * 128 + 4 + i); }
            f32x4 s0 = (f32x4){0.f, 0.f, 0.f, 0.f}, s1 = s0, q0 = s0, q1 = s0;
#pragma unroll
            for (int ai = 0; ai < 2; ++ai)
#pragma unroll
                for (int m = 0; m < 4; ++m) { const int row = row0 + ai * 128 + m * 16; const float rb = rbias ? rbias[row] : 0.f;
                    f32x4 v0 = acc[ai][bj][m][0] * c0 + rb, v1 = acc[ai][bj][m][1] * c1v + rb;
                    if (act) { v0 = gelu4(v0); v1 = gelu4(v1); }
                    s0 += v0; s1 += v1; q0 += v0 * v0; q1 += v1 * v1;
                    u32x4 w; w.x = cvt_pk_bf16(v0[0], v0[1]); w.y = cvt_pk_bf16(v0[2], v0[3]); w.z = cvt_pk_bf16(v1[0], v1[1]); w.w = cvt_pk_bf16(v1[2], v1[3]);
                    *(u32x4*)(O + (size_t)row * MTOK + col0 + bj * 128) = w; }
            if (psum) {
#pragma unroll
                for (int i = 0; i < 4; ++i) { s0[i] = row16_sum(s0[i]); s1[i] = row16_sum(s1[i]); q0[i] = row16_sum(q0[i]); q1[i] = row16_sum(q1[i]); }
                if (fr == 0) { const size_t p = (size_t)(u.pm * 2 + wr) * MTOK + col0 + bj * 128;
                    *(f32x4*)(psum + p) = s0; *(f32x4*)(psum + p + 4) = s1; *(f32x4*)(psq + p) = q0; *(f32x4*)(psq + p + 4) = q1; }
            }
        }
    }
};
struct EpiG1 {
    int attn, j;
    __device__ __forceinline__ void operator()(f32x4 (&acc)[2][2][4][2], const pg8::Unit& u, int wr, int wc, int fr, int fq, int lane) const {
        if (u.kind == 0) { EpiStore e{attn, j}; e(acc, u, wr, wc, fr, fq, lane); } else { EpiVT e{attn, j}; e(acc, u, wr, wc, fr, fq, lane); }
    }
};
struct EpiConv {
    int L; LAS float* X;
    __device__ __forceinline__ void operator()(f32x4 (&acc)[2][2][4][2], const pg8::Unit& u, int wr, int wc, int fr, int fq, int lane) const {
        unsigned char* ws = KP.ws;
        bf16_t* O = (bf16_t*)(ws + WS_BIG); const float* cw = KP.in[13] + (size_t)L * 3 * DFF; const float* cb = KP.in[14] + (size_t)L * DFF; const float* rowss = (const float*)(ws + WS_ROWSS);
        const bool seq_start = (u.pm & 15) == 0;
#pragma unroll
        for (int ai = 0; ai < 2; ++ai)
#pragma unroll
            for (int m = 0; m < 4; ++m) { const float r = rstd_of(rowss, u.pm * 256 + ai * 128 + wr * 64 + m * 16 + fr);
#pragma unroll
                for (int bj = 0; bj < 2; ++bj)
#pragma unroll
                    for (int n = 0; n < 2; ++n) acc[ai][bj][m][n] *= r; }
        const int cl = wc * 32 + 8 * fq;
        const int f0 = u.pn * 128 + cl;
        if (fr >= 14) {
#pragma unroll
            for (int ai = 0; ai < 2; ++ai)
#pragma unroll
                for (int n = 0; n < 2; ++n) *(LAS f32x4*)(X + ((ai * 2 + wr) * 2 + (fr - 14)) * 128 + cl + 4 * n) = acc[ai][0][3][n];
            if (wr == 1) {
                float* sb1 = (float*)(ws + WS_SB1) + (size_t)(u.pm * 2 + (fr - 14)) * DFF + f0;
#pragma unroll
                for (int n = 0; n < 2; ++n) *(f32x4*)(sb1 + 4 * n) = acc[1][0][3][n];
            }
        }
        if (wr == 0 && fr < 2 && !seq_start) {
            float* sg = (float*)(ws + WS_SBG0) + (size_t)(u.pm * 2 + fr) * DFF + f0; float* su = (float*)(ws + WS_SBU0) + (size_t)(u.pm * 2 + fr) * DFF + f0;
#pragma unroll
            for (int n = 0; n < 2; ++n) { *(f32x4*)(sg + 4 * n) = acc[0][0][0][n]; *(f32x4*)(su + 4 * n) = acc[0][1][0][n]; }
        }
        asm volatile("s_waitcnt lgkmcnt(0)" ::: "memory"); __builtin_amdgcn_s_barrier(); asm volatile("" ::: "memory");
        u32x2 hp[2][4];
#pragma unroll
        for (int n = 0; n < 2; ++n) {
            const f32x4 w0 = *(const f32x4*)(cw + f0 + 4 * n), w1 = *(const f32x4*)(cw + DFF + f0 + 4 * n), w2 = *(const f32x4*)(cw + 2 * DFF + f0 + 4 * n), wb = *(const f32x4*)(cb + f0 + 4 * n);
#pragma unroll
            for (int ai = 0; ai < 2; ++ai) {
                const int blk = ai * 2 + wr;
                f32x4 pr1 = (f32x4){0.f, 0.f, 0.f, 0.f}, pr2 = pr1;
                if (blk > 0 && fr < 2) { pr2 = *(const LAS f32x4*)(X + ((blk - 1) * 2 + fr) * 128 + cl + 4 * n); pr1 = *(const LAS f32x4*)(X + ((blk - 1) * 2 + 1) * 128 + cl + 4 * n); }
#pragma unroll
                for (int m = 0; m < 4; ++m) {
                    const int lr = ai * 128 + wr * 64 + m * 16 + fr;
                    const f32x4 cur = acc[ai][0][m][n];
                    f32x4 r1, r2;
#pragma unroll
                    for (int i = 0; i < 4; ++i) { r1[i] = dpp_f<0x121>(cur[i]); r2[i] = dpp_f<0x122>(cur[i]); }
                    const f32x4 p1 = (fr >= 1) ? r1 : pr1, p2 = (fr >= 2) ? r2 : pr2;
                    pr1 = r1; pr2 = r2;
                    const f32x4 gc = wb + w0 * p2 + w1 * p1 + w2 * cur;
                    const f32x4 hv = gelu4(gc) * acc[ai][1][m][n];
                    u32x2 w; w.x = cvt_pk_bf16(hv[0], hv[1]); w.y = cvt_pk_bf16(hv[2], hv[3]);
                    if (n == 0) hp[ai][m] = w;
                    else if (lr >= 2 || seq_start) *(u32x4*)(O + (size_t)(u.pm * 256 + lr) * DFF + f0) = (u32x4){hp[ai][m].x, hp[ai][m].y, w.x, w.y};
                }
            }
        }
    }
};
__device__ __forceinline__ void ffn_fixup(int pm, int L, int tid) {
    if ((pm & 15) == 0) return;
    unsigned char* ws = KP.ws;
    const float* sg0 = (const float*)(ws + WS_SBG0) + (size_t)pm * 2 * DFF; const float* su0 = (const float*)(ws + WS_SBU0) + (size_t)pm * 2 * DFF; const float* sp = (const float*)(ws + WS_SB1) + (size_t)(pm - 1) * 2 * DFF;
    const float* cw = KP.in[13] + (size_t)L * 3 * DFF; const float* cb = KP.in[14] + (size_t)L * DFF; bf16_t* O = (bf16_t*)(ws + WS_BIG);
    for (int idx = tid; idx < 2 * (DFF / 4); idx += NTHREADS) {
        const int lr = idx / (DFF / 4), f = 4 * (idx % (DFF / 4));
        const f32x4 cur = *(const f32x4*)(sg0 + lr * DFF + f), uu = *(const f32x4*)(su0 + lr * DFF + f);
        const f32x4 p1 = lr == 0 ? *(const f32x4*)(sp + DFF + f) : *(const f32x4*)(sg0 + f);
        const f32x4 p2 = lr == 0 ? *(const f32x4*)(sp + f) : *(const f32x4*)(sp + DFF + f);
        const f32x4 gc = *(const f32x4*)(cb + f) + *(const f32x4*)(cw + f) * p2 + *(const f32x4*)(cw + DFF + f) * p1 + *(const f32x4*)(cw + 2 * DFF + f) * cur;
        const f32x4 hv = gelu4(gc) * uu;
        u32x2 w; w.x = cvt_pk_bf16(hv[0], hv[1]); w.y = cvt_pk_bf16(hv[2], hv[3]);
        *(u32x2*)(O + (size_t)(pm * 256 + lr) * DFF + f) = w;
    }
}
struct EpiResid {
    int hl; LAS float* Pt; LAS float* St;
    __device__ __forceinline__ void operator()(f32x4 (&acc)[2][2][4][2], const pg8::Unit& u, int wr, int wc, int fr, int fq, int lane) const {
        unsigned char* ws = KP.ws; const int L = hl >> 1;
        bf16_t* XB = (bf16_t*)(ws + WS_XN); float* OUT = (hl + 1 == 2 * DEPTH) ? KP.out : nullptr;
        const float* cbias = (hl & 3) == 0 ? KP.in[5] + (size_t)(L >> 1) * DM : nullptr;
        const float* gpost = ((hl & 1) == 0 ? KP.in[17] : KP.in[19]) + (size_t)L * DM;
        unsigned long long* slots = (unsigned long long*)(ws + WS_SLOT); const unsigned tag = (unsigned)(hl + 1); float* rowss = (float*)(ws + WS_ROWSS);
        const int wid = wr * 4 + wc, tid = wid * 64 + lane;
        const int row0 = u.pm * 256 + wr * 64 + fr, col0 = u.pn * 256 + wc * 32 + 8 * fq;
        if (cbias) {
#pragma unroll
            for (int bj = 0; bj < 2; ++bj)
#pragma unroll
                for (int n = 0; n < 2; ++n) { const f32x4 bv = *(const f32x4*)(cbias + col0 + bj * 128 + 4 * n);
#pragma unroll
                    for (int ai = 0; ai < 2; ++ai)
#pragma unroll
                        for (int m = 0; m < 4; ++m) acc[ai][bj][m][n] += bv; }
        }
#pragma unroll
        for (int ai = 0; ai < 2; ++ai)
#pragma unroll
            for (int m = 0; m < 4; ++m) { float sq = 0.f;
#pragma unroll
                for (int bj = 0; bj < 2; ++bj)
#pragma unroll
                    for (int n = 0; n < 2; ++n) { const f32x4 v = acc[ai][bj][m][n]; sq += (v[0] * v[0] + v[1] * v[1]) + (v[2] * v[2] + v[3] * v[3]); }
                sq += __shfl_xor(sq, 16); sq += __shfl_xor(sq, 32);
                if (fq == 0) Pt[(ai * 128 + wr * 64 + m * 16 + fr) * 4 + wc] = sq; }
        asm volatile("s_waitcnt lgkmcnt(0)" ::: "memory"); __builtin_amdgcn_s_barrier(); asm volatile("" ::: "memory");
        if (tid < 256) {
            const f32x4 p = *(const LAS f32x4*)(Pt + tid * 4);
            __hip_atomic_store(slots + (size_t)(u.pm * 256 + tid) * 4 + u.pn, ((unsigned long long)tag << 32) | (unsigned long long)__float_as_uint((p[0] + p[1]) + (p[2] + p[3])), __ATOMIC_RELAXED, __HIP_MEMORY_SCOPE_AGENT);
        }
        asm volatile("" ::: "memory");
        u32x4 xr[4][2];
#pragma unroll
        for (int m = 0; m < 4; ++m)
#pragma unroll
            for (int bj = 0; bj < 2; ++bj) xr[m][bj] = *(const u32x4*)(XB + (size_t)(row0 + m * 16) * DM + col0 + bj * 128);
        f32x4 gp[2][2];
#pragma unroll
        for (int bj = 0; bj < 2; ++bj)
#pragma unroll
            for (int n = 0; n < 2; ++n) gp[bj][n] = *(const f32x4*)(gpost + col0 + bj * 128 + 4 * n);
        if (tid < 256) {
            const unsigned long long* sl = slots + (size_t)(u.pm * 256 + tid) * 4; float t = 0.f; unsigned sp = 0;
            for (;;) {
                const unsigned long long a0 = __hip_atomic_load(sl + 0, __ATOMIC_RELAXED, __HIP_MEMORY_SCOPE_AGENT), a1 = __hip_atomic_load(sl + 1, __ATOMIC_RELAXED, __HIP_MEMORY_SCOPE_AGENT),
                                         a2 = __hip_atomic_load(sl + 2, __ATOMIC_RELAXED, __HIP_MEMORY_SCOPE_AGENT), a3 = __hip_atomic_load(sl + 3, __ATOMIC_RELAXED, __HIP_MEMORY_SCOPE_AGENT);
                const bool ok = ((unsigned)(a0 >> 32) == tag) && ((unsigned)(a1 >> 32) == tag) && ((unsigned)(a2 >> 32) == tag) && ((unsigned)(a3 >> 32) == tag);
                t = (__uint_as_float((unsigned)a0) + __uint_as_float((unsigned)a1)) + (__uint_as_float((unsigned)a2) + __uint_as_float((unsigned)a3));
                if (__builtin_amdgcn_ballot_w64(!ok) == 0ull || ++sp > (1u << 22)) break;
                __builtin_amdgcn_s_sleep(1);
            }
            St[tid] = __builtin_amdgcn_rsqf(t * (1.f / DM) + EPS);
        }
        asm volatile("s_waitcnt lgkmcnt(0)" ::: "memory"); __builtin_amdgcn_s_barrier(); asm volatile("" ::: "memory");
#pragma unroll
        for (int ai = 0; ai < 2; ++ai) {
            if (ai == 1) {
                asm volatile("" ::: "memory");
#pragma unroll
                for (int m = 0; m < 4; ++m)
#pragma unroll
                    for (int bj = 0; bj < 2; ++bj) xr[m][bj] = *(const u32x4*)(XB + (size_t)(row0 + 128 + m * 16) * DM + col0 + bj * 128);
            }
#pragma unroll
            for (int m = 0; m < 4; ++m) { const int lr = ai * 128 + wr * 64 + m * 16 + fr; const float r = St[lr]; float sq = 0.f;
                const size_t off = (size_t)(u.pm * 256 + lr) * DM + col0;
#pragma unroll
                for (int bj = 0; bj < 2; ++bj) { const u32x4 xw = xr[m][bj];
                    const f32x4 x0 = (f32x4){bf_lo(xw.x), bf_hi(xw.x), bf_lo(xw.y), bf_hi(xw.y)}, x1 = (f32x4){bf_lo(xw.z), bf_hi(xw.z), bf_lo(xw.w), bf_hi(xw.w)};
                    const f32x4 o0 = x0 + acc[ai][bj][m][0] * r * gp[bj][0], o1 = x1 + acc[ai][bj][m][1] * r * gp[bj][1];
                    sq += ((o0[0] * o0[0] + o0[1] * o0[1]) + (o0[2] * o0[2] + o0[3] * o0[3])) + ((o1[0] * o1[0] + o1[1] * o1[1]) + (o1[2] * o1[2] + o1[3] * o1[3]));
                    if (OUT) { *(f32x4*)(OUT + off + bj * 128) = o0; *(f32x4*)(OUT + off + bj * 128 + 4) = o1; }
                    else { u32x4 w; w.x = cvt_pk_bf16(o0[0], o0[1]); w.y = cvt_pk_bf16(o0[2], o0[3]); w.z = cvt_pk_bf16(o1[0], o1[1]); w.w = cvt_pk_bf16(o1[2], o1[3]); *(u32x4*)(XB + off + bj * 128) = w; } }
                sq += __shfl_xor(sq, 16); sq += __shfl_xor(sq, 32);
                if (fq == 0) Pt[lr * 4 + wc] = sq; }
        }
        asm volatile("s_waitcnt lgkmcnt(0)" ::: "memory"); __builtin_amdgcn_s_barrier(); asm volatile("" ::: "memory");
        if (tid < 256) { const f32x4 p = *(const LAS f32x4*)(Pt + tid * 4); rowss[(size_t)(u.pm * 256 + tid) * 4 + u.pn] = (p[0] + p[1]) + (p[2] + p[3]); }
    }
};

struct ConvSrc { const float* W; int K, N; bf16_t* WT; int mode; const float* gk; };
__device__ __forceinline__ void conv_load(const ConvSrc& c, int item, int lane, float (&R)[32]) {
    const int nblk = c.N / 32, kb = item / nblk, nb = item % nblk, k0 = 64 * kb, n0 = 32 * nb;
#pragma unroll
    for (int i = 0; i < 32; ++i) { const int kk = 2 * i + (lane >> 5); const float gv = c.gk ? c.gk[k0 + kk] : 1.f; R[i] = c.W[(size_t)(k0 + kk) * c.N + n0 + (lane & 31)] * gv; }
}
__device__ __forceinline__ void conv_store(const ConvSrc& c, int item, int lane, LAS float* scr, const float (&R)[32]) {
    const int nblk = c.N / 32, kb = item / nblk, nb = item % nblk, k0 = 64 * kb, n0 = 32 * nb;
#pragma unroll
    for (int i = 0; i < 32; ++i) scr[(2 * i + (lane >> 5)) * 33 + (lane & 31)] = R[i];
}
__device__ __forceinline__ void conv_finish(const ConvSrc& c, int item, int lane, LAS float* scr) {
    const int nblk = c.N / 32, kb = item / nblk, nb = item % nblk, k0 = 64 * kb, n0 = 32 * nb;
    asm volatile("s_waitcnt lgkmcnt(0)" ::: "memory");
    int d0 = n0;
    if (c.mode == 1) { const int f = (n0 < DFF) ? n0 : n0 - DFF; d0 = 256 * (f >> 7) + (f & 127) + ((n0 < DFF) ? 0 : 128); }
    const int cc = lane & 7;
#pragma unroll
    for (int j = 0; j < 4; ++j) { const int n = (lane >> 3) + 8 * j; const LAS float* sp = scr + (8 * cc) * 33 + n;
        u32x4 o; o.x = cvt_pk_bf16(sp[0 * 33], sp[1 * 33]); o.y = cvt_pk_bf16(sp[2 * 33], sp[3 * 33]); o.z = cvt_pk_bf16(sp[4 * 33], sp[5 * 33]); o.w = cvt_pk_bf16(sp[6 * 33], sp[7 * 33]);
        *(u32x4*)(c.WT + (size_t)(d0 + n) * c.K + k0 + 8 * cc) = o; }
    asm volatile("s_waitcnt lgkmcnt(0)" ::: "memory");
}
__device__ __forceinline__ ConvSrc conv_pick(const ConvSrc a, const ConvSrc b, bool first) {
    ConvSrc c; c.W = first ? a.W : b.W; c.K = first ? a.K : b.K; c.N = first ? a.N : b.N; c.WT = first ? a.WT : b.WT; c.mode = first ? a.mode : b.mode; c.gk = first ? a.gk : b.gk; return c;
}
__device__ __forceinline__ void convert_pair(const ConvSrc a, int I1, const ConvSrc b, int I2, LAS float* scr, int gw, int NGW, int lane) {
    float R[32];
    int it = gw;
    if (it < I1 + I2) { const ConvSrc c = conv_pick(a, b, it < I1); conv_load(c, it < I1 ? it : it - I1, lane, R); }
    while (it < I1 + I2) {
        const int nx = it + NGW;
        const ConvSrc c = conv_pick(a, b, it < I1); const int ci = it < I1 ? it : it - I1;
        conv_store(c, ci, lane, scr, R);
        if (nx < I1 + I2) { const ConvSrc cn = conv_pick(a, b, nx < I1); conv_load(cn, nx < I1 ? nx : nx - I1, lane, R); }
        conv_finish(c, ci, lane, scr);
        it = nx;
    }
}

__device__ __forceinline__ void convert_mixer(const Params& P, int L, LAS float* scr, int gw, int NGW, int lane) {
    const int j = L >> 1;
    unsigned char* wm = P.ws + WS_WMIX;
    if ((L & 1) == 0) {
        const ConvSrc a{P.in[1] + (size_t)j * DM * QKV, DM, QKV, (bf16_t*)(wm + WM_A), 0, P.in[16] + (size_t)L * DM};
        const ConvSrc b{P.in[4] + (size_t)j * DM * DM, DM, DM, (bf16_t*)(wm + WM_B), 0, nullptr};
        convert_pair(a, (DM / 64) * (QKV / 32), b, (DM / 64) * (DM / 32), scr, gw, NGW, lane);
    } else {
        const ConvSrc a{P.in[6] + (size_t)j * DM * 2 * SH, DM, 2 * SH, (bf16_t*)(wm + WM_A), 0, P.in[16] + (size_t)L * DM};
        const ConvSrc b{P.in[11] + (size_t)j * SH * DM, SH, DM, (bf16_t*)(wm + WM_B), 0, nullptr};
        convert_pair(a, (DM / 64) * (2 * SH / 32), b, (SH / 64) * (DM / 32), scr, gw, NGW, lane);
        const float* wsp = P.in[9] + (size_t)j * NGRP * CHK * CHK;
        bf16_t* wsb = (bf16_t*)(wm + WM_S);
        for (int e = (gw * 64 + lane) * 4; e < NGRP * CHK * CHK; e += NGW * 64 * 4) {
            const f32x4 v = *(const f32x4*)(wsp + e); const int t = (e >> 7) & 127, s0 = e & 127;
            u32x2 o; o.x = cvt_pk_bf16(s0 <= t ? v[0] : 0.f, s0 + 1 <= t ? v[1] : 0.f); o.y = cvt_pk_bf16(s0 + 2 <= t ? v[2] : 0.f, s0 + 3 <= t ? v[3] : 0.f);
            *(u32x2*)(wsb + e) = o;
        }
    }
}
__device__ __forceinline__ void convert_ffn(const Params& P, int L, LAS float* scr, int gw, int NGW, int lane) {
    unsigned char* wf = P.ws + WS_WFFN;
    const ConvSrc a{P.in[12] + (size_t)L * DM * 2 * DFF, DM, 2 * DFF, (bf16_t*)(wf + WF_A), 1, P.in[18] + (size_t)L * DM};
    const ConvSrc b{P.in[15] + (size_t)L * DFF * DM, DFF, DM, (bf16_t*)(wf + WF_B), 0, nullptr};
    convert_pair(a, (DM / 64) * (2 * DFF / 32), b, (DFF / 64) * (DM / 32), scr, gw, NGW, lane);
}

__device__ __forceinline__ void xb0_phase(const float* x, bf16_t* xb, float* rowss, int gw, int NGW, int lane) {
    for (int r = gw; r < MTOK; r += 2 * NGW) {
        f32x4 v[2][4];
#pragma unroll
        for (int k = 0; k < 2; ++k)
#pragma unroll
            for (int j = 0; j < 2; ++j) { const float* p = x + (size_t)(r + k * NGW) * DM + 8 * lane + 512 * j;
                v[k][2 * j] = __builtin_nontemporal_load((const f32x4*)p); v[k][2 * j + 1] = __builtin_nontemporal_load((const f32x4*)(p + 4)); }
#pragma unroll
        for (int k = 0; k < 2; ++k) {
            float ss = 0.f;
#pragma unroll
            for (int j = 0; j < 4; ++j) ss += (v[k][j][0] * v[k][j][0] + v[k][j][1] * v[k][j][1]) + (v[k][j][2] * v[k][j][2] + v[k][j][3] * v[k][j][3]);
            ss = wave_sum(ss);
            bf16_t* o = xb + (size_t)(r + k * NGW) * DM + 8 * lane;
#pragma unroll
            for (int j = 0; j < 2; ++j) { u32x4 w; w.x = cvt_pk_bf16(v[k][2 * j][0], v[k][2 * j][1]); w.y = cvt_pk_bf16(v[k][2 * j][2], v[k][2 * j][3]);
                w.z = cvt_pk_bf16(v[k][2 * j + 1][0], v[k][2 * j + 1][1]); w.w = cvt_pk_bf16(v[k][2 * j + 1][2], v[k][2 * j + 1][3]); *(u32x4*)(o + 512 * j) = w; }
            if (lane == 0) *(f32x4*)(rowss + (size_t)(r + k * NGW) * 4) = (f32x4){ss, 0.f, 0.f, 0.f};
        }
    }
}

__device__ __forceinline__ void attn_phase(LAS unsigned char* lds, const bf16_t* QK, const bf16_t* VT, bf16_t* O, const float* sinks, int G, int bid) {
    constexpr int LDK = 72, LDV = 280;
    LAS bf16_t* Ks = (LAS bf16_t*)lds;
    LAS bf16_t* Vt = Ks + 272 * LDK;
    int tid = threadIdx.x; asm volatile("" : "+v"(tid));
    const int lane = tid & 63, w = tid >> 6, fr = lane & 15, fq = lane >> 4;
    const float L2E = 1.4426950408889634f;
    unsigned zu = 0u; asm volatile("" : "+v"(zu));
    u32x4 kreg[4], vreg[4];
#define AT_LOAD(un) do { const int nb_ = (un) & 31, g_ = ((un) >> 5) & 3, b_ = (un) >> 7, seq0_ = b_ * SEQ, blk0_ = nb_ * 128; \
        _Pragma("unroll") for (int pass = 0; pass < 4; ++pass) { const int kj = pass * 64 + (tid >> 3), seg = tid & 7, pos = blk0_ - 128 + kj; \
            kreg[pass] = (u32x4){zu, zu, zu, zu}; if (pos >= 0) kreg[pass] = *(const u32x4*)(QK + (size_t)(seq0_ + pos) * QKD + 1024 + g_ * 64 + seg * 8); } \
        _Pragma("unroll") for (int pass = 0; pass < 4; ++pass) { const int d = pass * 16 + (tid >> 5), seg = tid & 31, pos = blk0_ - 128 + seg * 8; \
            vreg[pass] = (u32x4){zu, zu, zu, zu}; if (pos >= 0) vreg[pass] = *(const u32x4*)(VT + (size_t)(g_ * 64 + d) * MTOK + seq0_ + pos); } } while (0)
    if (bid < BATCH * 4 * 32) AT_LOAD(bid);
    for (int unit = bid; unit < BATCH * 4 * 32; unit += G) {
        const int nb = unit & 31, g = (unit >> 5) & 3, b = unit >> 7;
        const int seq0 = b * SEQ, blk0 = nb * 128;
#pragma unroll
        for (int pass = 0; pass < 4; ++pass) *(LAS u32x4*)(Ks + (pass * 64 + (tid >> 3)) * LDK + (tid & 7) * 8) = kreg[pass];
        if (tid < 128) *(LAS u32x4*)(Ks + (256 + (tid >> 3)) * LDK + (tid & 7) * 8) = (u32x4){zu, zu, zu, zu};
#pragma unroll
        for (int pass = 0; pass < 4; ++pass) *(LAS u32x4*)(Vt + (pass * 16 + (tid >> 5)) * LDV + (tid & 31) * 8) = vreg[pass];
        if (tid < 128) *(LAS u32x4*)(Vt + (tid >> 1) * LDV + 256 + (tid & 1) * 8) = (u32x4){zu, zu, zu, zu};
        const int r = w >> 1, half = w & 1, h = g * 4 + r;
        const bf16_t* qbase = QK + (size_t)(seq0 + blk0 + 64 * half + fr) * QKD + h * 64 + 8 * fq;
        bf16x8 qn[2];
#pragma unroll
        for (int kk = 0; kk < 2; ++kk) qn[kk] = *(const bf16x8*)(qbase + 32 * kk);
        if (unit + G < BATCH * 4 * 32) AT_LOAD(unit + G);
        __syncthreads();
        const float slope2 = __builtin_amdgcn_exp2f(-0.5f * (float)(h + 1)) * L2E, sink2 = sinks[h] * L2E;
        const float c2 = 0.125f * L2E;
#pragma unroll 1
        for (int qt = 0; qt < 4; ++qt) {
            const int j0 = 4 * half + qt, q0 = 16 * j0;
            const size_t tokq = (size_t)(seq0 + blk0 + q0 + fr);
            bf16x8 qf[2]; qf[0] = qn[0]; qf[1] = qn[1];
            if (qt < 3) {
#pragma unroll
                for (int kk = 0; kk < 2; ++kk) qn[kk] = *(const bf16x8*)(qbase + (size_t)(16 * (qt + 1)) * QKD + 32 * kk);
            }
            f32x4 S[10];
#pragma unroll
            for (int jj = 0; jj < 9; ++jj) {
                S[jj] = (f32x4){0.f, 0.f, 0.f, 0.f};
#pragma unroll
                for (int kk = 0; kk < 2; ++kk) { const bf16x8 kf = *(const LAS bf16x8*)(Ks + (16 * (j0 + jj) + fr) * LDK + 32 * kk + 8 * fq);
                    S[jj] = __builtin_amdgcn_mfma_f32_16x16x32_bf16(kf, qf[kk], S[jj], 0, 0, 0); }
            }
            float mx = sink2;
#pragma unroll
            for (int jj = 0; jj < 9; ++jj)
#pragma unroll
                for (int i = 0; i < 4; ++i) {
                    const int kjr = 16 * jj + 4 * fq + i;
                    const int dist = fr + 128 - kjr;
                    const bool valid = (dist >= 0) && (dist < 128) && (blk0 - 128 + q0 + kjr >= 0);
                    const float sv = valid ? (S[jj][i] * c2 - slope2 * (float)dist) : -INFINITY;
                    S[jj][i] = sv; mx = fmaxf(mx, sv);
                }
            mx = fmaxf(mx, __shfl_xor(mx, 16)); mx = fmaxf(mx, __shfl_xor(mx, 32));
            float sum = 0.f;
#pragma unroll
            for (int jj = 0; jj < 9; ++jj)
#pragma unroll
                for (int i = 0; i < 4; ++i) { const float p = __builtin_amdgcn_exp2f(S[jj][i] - mx); S[jj][i] = p; sum += p; }
            S[9] = (f32x4){0.f, 0.f, 0.f, 0.f};
            sum += __shfl_xor(sum, 16); sum += __shfl_xor(sum, 32);
            const float inv = 1.0f / (sum + __builtin_amdgcn_exp2f(sink2 - mx));
            f32x4 oa[4];
#pragma unroll
            for (int dt = 0; dt < 4; ++dt) oa[dt] = (f32x4){0.f, 0.f, 0.f, 0.f};
#pragma unroll
            for (int ks = 0; ks < 5; ++ks) {
                u32x4 pw; pw.x = cvt_pk_bf16(S[2 * ks][0], S[2 * ks][1]); pw.y = cvt_pk_bf16(S[2 * ks][2], S[2 * ks][3]);
                pw.z = cvt_pk_bf16(S[2 * ks + 1][0], S[2 * ks + 1][1]); pw.w = cvt_pk_bf16(S[2 * ks + 1][2], S[2 * ks + 1][3]);
                const bf16x8 pf = __builtin_bit_cast(bf16x8, pw);
#pragma unroll
                for (int dt = 0; dt < 4; ++dt) {
                    const LAS bf16_t* vp = Vt + (16 * dt + fr) * LDV + 16 * (j0 + 2 * ks) + 4 * fq;
                    const u32x2 lo = *(const LAS u32x2*)vp, hi = *(const LAS u32x2*)(vp + 16);
                    const u32x4 vv = (u32x4){lo.x, lo.y, hi.x, hi.y};
                    oa[dt] = __builtin_amdgcn_mfma_f32_16x16x32_bf16(__builtin_bit_cast(bf16x8, vv), pf, oa[dt], 0, 0, 0);
                }
            }
            bf16_t* op = O + tokq * DM + h * 64 + 16 * (fq & 1) + 8 * (fq >> 1);
#pragma unroll
            for (int dt = 0; dt < 4; dt += 2) {
                const unsigned ax = cvt_pk_bf16(oa[dt][0] * inv, oa[dt][1] * inv), ay = cvt_pk_bf16(oa[dt][2] * inv, oa[dt][3] * inv);
                const unsigned bx = cvt_pk_bf16(oa[dt + 1][0] * inv, oa[dt + 1][1] * inv), by = cvt_pk_bf16(oa[dt + 1][2] * inv, oa[dt + 1][3] * inv);
                const auto s0 = __builtin_amdgcn_permlane16_swap(ax, bx, false, false), s1 = __builtin_amdgcn_permlane16_swap(ay, by, false, false);
                *(u32x4*)(op + 16 * dt) = (u32x4){s0[0], s1[0], s0[1], s1[1]};
            }
        }
        __syncthreads();
    }
#undef AT_LOAD
}

__device__ __forceinline__ void spatial_phase(LAS unsigned char* lds, const bf16_t* VT, bf16_t* U, const bf16_t* Wsb, const float* psum, const float* psq,
                                              const float* lng, const float* lnb, const float* bs, int G, int bid) {
    constexpr int LDA = 136, NU = (MTOK / CHK) * NGRP;
    LAS bf16_t* As = (LAS bf16_t*)lds;
    LAS bf16_t* Bs = As + 2 * 128 * LDA;
    LAS float* tbl = (LAS float*)(Bs + 128 * LDA);
    LAS float* st = tbl + 512;
    LAS float* red = st + 256;
    int tid = threadIdx.x; asm volatile("" : "+v"(tid));
    const int lane = tid & 63, w = tid >> 6, fr = lane & 15, fq = lane >> 4;
    const int srow = tid >> 4, sseg = tid & 15, tt = tid & 127, part = tid >> 7;
    int unit = bid * 8;
    if (unit >= NU) return;
    float sp[12], lgn[4], lbn[4], bsn = 0.f; u32x4 wraw[4], R[4], uvn[4], uvc[4];
#define SP_LOAD_SP(un) do { const int tok0_ = ((un) >> 3) * CHK; if (((un) & 7) == 0) { _Pragma("unroll") for (int k = 0; k < 6; ++k) { sp[k] = psum[(size_t)(part * 6 + k) * MTOK + tok0_ + tt]; sp[6 + k] = psq[(size_t)(part * 6 + k) * MTOK + tok0_ + tt]; } } \
        if (tid < 128) bsn = bs[((un) & 7) * CHK + tid]; } while (0)
#define SP_LOAD_W(un) do { const int g_ = (un) & 7; _Pragma("unroll") for (int p = 0; p < 4; ++p) wraw[p] = *(const u32x4*)(Wsb + (size_t)(g_ * CHK + p * 32 + srow) * CHK + sseg * 8); } while (0)
#define SP_LOAD_R(un, db_) do { const int g_ = (un) & 7, tok0_ = ((un) >> 3) * CHK; _Pragma("unroll") for (int p = 0; p < 4; ++p) { const int f_ = g_ * GD + (db_) * 128 + p * 32 + srow; \
        R[p] = *(const u32x4*)(VT + (size_t)f_ * MTOK + tok0_ + sseg * 8); lgn[p] = lng[f_]; lbn[p] = lnb[f_]; } } while (0)
#define SP_LOAD_UV(un, db_) do { const int g_ = (un) & 7, tok0_ = ((un) >> 3) * CHK; _Pragma("unroll") for (int q = 0; q < 4; ++q) uvn[q] = *(const u32x4*)(U + (size_t)(tok0_ + 16 * (2 * q + (fq & 1)) + fr) * SH + g_ * GD + (db_) * 128 + 16 * w + 8 * (fq >> 1)); } while (0)
#define SP_WRITE_A(buf) do { _Pragma("unroll") for (int p = 0; p < 4; ++p) { float o_[8]; const float lg_ = lgn[p], lb_ = lbn[p]; \
        _Pragma("unroll") for (int e = 0; e < 4; ++e) { const unsigned wv_ = R[p][e]; const f32x4 m_ = *(const LAS f32x4*)(st + 2 * (sseg * 8 + 2 * e)); \
            o_[2 * e] = (bf_lo(wv_) - m_[0]) * m_[1] * lg_ + lb_; o_[2 * e + 1] = (bf_hi(wv_) - m_[2]) * m_[3] * lg_ + lb_; } \
        u32x4 pk_; pk_.x = cvt_pk_bf16(o_[0], o_[1]); pk_.y = cvt_pk_bf16(o_[2], o_[3]); pk_.z = cvt_pk_bf16(o_[4], o_[5]); pk_.w = cvt_pk_bf16(o_[6], o_[7]); \
        *(LAS u32x4*)(As + (buf) * 128 * LDA + (p * 32 + srow) * LDA + sseg * 8) = pk_; } } while (0)
    SP_LOAD_SP(unit); SP_LOAD_W(unit); SP_LOAD_R(unit, 0); SP_LOAD_UV(unit, 0);
    for (;;) {
        const int g = unit & 7, tok0 = (unit >> 3) * CHK;
        const int nu = ((unit & 7) < 7) ? unit + 1 : unit + 8 * G - 7;
        const bool has_next = nu < NU;
        if (g == 0) { const float s6 = ((sp[0] + sp[1]) + (sp[2] + sp[3])) + (sp[4] + sp[5]), q6 = ((sp[6] + sp[7]) + (sp[8] + sp[9])) + (sp[10] + sp[11]);
          *(LAS f32x2*)(red + (part * 128 + tt) * 2) = (f32x2){s6, q6}; }
        __syncthreads();
        if (g == 0 && tid < 128) {
            const f32x2 a0 = *(const LAS f32x2*)(red + tid * 2), a1 = *(const LAS f32x2*)(red + (128 + tid) * 2), a2 = *(const LAS f32x2*)(red + (256 + tid) * 2), a3 = *(const LAS f32x2*)(red + (384 + tid) * 2);
            const float mean = ((a0.x + a1.x) + (a2.x + a3.x)) * (1.f / SH), var = fmaxf(((a0.y + a1.y) + (a2.y + a3.y)) * (1.f / SH) - mean * mean, 0.f);
            *(LAS f32x2*)(st + 2 * tid) = (f32x2){mean, __builtin_amdgcn_rsqf(var + EPS)};
        }
        if (tid < 128) tbl[tid] = bsn;
        __syncthreads();
#pragma unroll
        for (int p = 0; p < 4; ++p) *(LAS u32x4*)(Bs + (p * 32 + srow) * LDA + sseg * 8) = wraw[p];
        SP_WRITE_A(0);
#pragma unroll
        for (int q = 0; q < 4; ++q) uvc[q] = uvn[q];
        __syncthreads();
#pragma unroll
        for (int db = 0; db < 3; ++db) {
            const LAS bf16_t* Ab = As + (db & 1) * 128 * LDA;
            if (db < 2) { SP_LOAD_R(unit, db + 1); SP_LOAD_UV(unit, db + 1); }
            else if (has_next) { SP_LOAD_SP(nu); SP_LOAD_W(nu); SP_LOAD_R(nu, 0); SP_LOAD_UV(nu, 0); }
            const int fcol = g * GD + db * 128 + 16 * w + 4 * fq;
            f32x4 acc[8];
#pragma unroll
            for (int n = 0; n < 8; ++n) acc[n] = (f32x4){0.f, 0.f, 0.f, 0.f};
#pragma unroll
            for (int kk = 0; kk < 4; ++kk) {
                const bf16x8 a = *(const LAS bf16x8*)(Ab + (16 * w + fr) * LDA + 32 * kk + 8 * fq);
#pragma unroll
                for (int n = 0; n < 8; ++n) { const bf16x8 bb = *(const LAS bf16x8*)(Bs + (16 * n + fr) * LDA + 32 * kk + 8 * fq);
                    acc[n] = __builtin_amdgcn_mfma_f32_16x16x32_bf16(a, bb, acc[n], 0, 0, 0); }
            }
#pragma unroll
            for (int q = 0; q < 4; ++q) {
                const float bsA = tbl[32 * q + fr], bsB = tbl[32 * q + 16 + fr];
                const u32x4 L = uvc[q];
                const auto u0 = __builtin_amdgcn_permlane16_swap(L.x, L.z, false, false), u1 = __builtin_amdgcn_permlane16_swap(L.y, L.w, false, false);
                const unsigned pAx = cvt_pk_bf16((acc[2 * q][0] + bsA) * bf_lo(u0[0]), (acc[2 * q][1] + bsA) * bf_hi(u0[0])), pAy = cvt_pk_bf16((acc[2 * q][2] + bsA) * bf_lo(u1[0]), (acc[2 * q][3] + bsA) * bf_hi(u1[0]));
                const unsigned pBx = cvt_pk_bf16((acc[2 * q + 1][0] + bsB) * bf_lo(u0[1]), (acc[2 * q + 1][1] + bsB) * bf_hi(u0[1])), pBy = cvt_pk_bf16((acc[2 * q + 1][2] + bsB) * bf_lo(u1[1]), (acc[2 * q + 1][3] + bsB) * bf_hi(u1[1]));
                const auto s0 = __builtin_amdgcn_permlane16_swap(pAx, pBx, false, false), s1 = __builtin_amdgcn_permlane16_swap(pAy, pBy, false, false);
                *(u32x4*)(U + (size_t)(tok0 + 16 * (2 * q + (fq & 1)) + fr) * SH + g * GD + db * 128 + 16 * w + 8 * (fq >> 1)) = (u32x4){s0[0], s1[0], s0[1], s1[1]};
            }
            if (db < 2) {
                SP_WRITE_A((db + 1) & 1);
#pragma unroll
                for (int q = 0; q < 4; ++q) uvc[q] = uvn[q];
                __syncthreads();
            }
        }
        if (!has_next) break;
        unit = nu;
    }
#undef SP_LOAD_SP
#undef SP_LOAD_W
#undef SP_LOAD_R
#undef SP_LOAD_UV
#undef SP_WRITE_A
}

#define XB_TMO      128
#define XB_XCNT(j)  (256  + 64 * (j))
#define XB_XSUB(j)  (1280 + 64 * (j))
#define XB_XGEN(j)  (2304 + 64 * (j))
#define XB_TOP      3328
#define XB_TOPGEN   3392
#define XCD_BAR_WORDS 3456
#define XB_SPIN_CAP (1u << 22)
__device__ __forceinline__ unsigned xb_ld(unsigned* p)              { return __hip_atomic_load(p, __ATOMIC_RELAXED, __HIP_MEMORY_SCOPE_AGENT); }
__device__ __forceinline__ unsigned xb_add(unsigned* p, unsigned v) { return __hip_atomic_fetch_add(p, v, __ATOMIC_RELAXED, __HIP_MEMORY_SCOPE_AGENT); }
__device__ __forceinline__ unsigned xb_xcc_id() { return (unsigned)__builtin_amdgcn_s_getreg((3 << 11) | 20) & 0xFu; }
#define XB_SPIN(cond, bar) do { unsigned _sp = 0; while (cond) { __builtin_amdgcn_s_sleep(1); \
    if ((++_sp & 255u) == 0u) { if (xb_ld(&(bar)[XB_TMO])) break; if (_sp > XB_SPIN_CAP) { atomicAdd(&(bar)[XB_TMO], 1u); break; } } } } while (0)
struct XcdBarrier { unsigned* bar; unsigned x; volatile LAS unsigned* st; };
__device__ __forceinline__ XcdBarrier xcd_barrier_post(unsigned* bar, volatile LAS unsigned* st) {
    XcdBarrier b; b.bar = bar; b.x = xb_xcc_id(); b.st = st;
    if (threadIdx.x == 0) (void)xb_add(&bar[XB_XCNT(b.x)], 1u);
    return b;
}
__device__ __forceinline__ void xcd_barrier_complete(unsigned* bar, unsigned x, unsigned& nloc, unsigned& nx) {
    const unsigned G = gridDim.x * gridDim.y * gridDim.z;
    unsigned sum, cnt, mine, sp = 0u;
    for (;;) {
        sum = 0u; cnt = 0u; mine = 0u;
#pragma unroll
        for (unsigned j = 0; j < 16; ++j) { const unsigned c = xb_ld(&bar[XB_XCNT(j)]); sum += c; cnt += (c > 0u) ? 1u : 0u; mine = (j == x) ? c : mine; }
        if (sum == G) break;
        __builtin_amdgcn_s_sleep(1);
        if ((++sp & 255u) == 0u) { if (xb_ld(&bar[XB_TMO])) break; if (sp > XB_SPIN_CAP) { atomicAdd(&bar[XB_TMO], 1u); break; } }
    }
    nloc = mine > 0u ? mine : 1u; nx = cnt > 0u ? cnt : 1u;
}
__device__ __forceinline__ void xcd_barrier(const XcdBarrier& b) {
    asm volatile("s_waitcnt vmcnt(0)" ::: "memory");
    __syncthreads();
    if (threadIdx.x == 0) {
        unsigned* bar = b.bar;
        __builtin_amdgcn_s_waitcnt(0);
        unsigned nloc = b.st[0], nx = b.st[1];
        if (nloc == 0u) { xcd_barrier_complete(bar, b.x, nloc, nx); b.st[0] = nloc; b.st[1] = nx; }
        const unsigned old = xb_add(&bar[XB_XSUB(b.x)], 1u);
        const unsigned gen = old / nloc;
        if (old + 1u == (gen + 1u) * nloc) {
            __builtin_amdgcn_fence(__ATOMIC_RELEASE, "agent");
            asm volatile("s_waitcnt vmcnt(0)" ::: "memory");
            const unsigned og = xb_add(&bar[XB_TOP], 1u);
            const unsigned tg = og / nx;
            if (og + 1u == (tg + 1u) * nx) xb_add(&bar[XB_TOPGEN], 1u);
            else XB_SPIN(xb_ld(&bar[XB_TOPGEN]) == tg, bar);
            __builtin_amdgcn_fence(__ATOMIC_ACQUIRE, "agent");
            xb_add(&bar[XB_XGEN(b.x)], 1u);
            asm volatile("s_waitcnt vmcnt(0)" ::: "memory");
        } else {
            XB_SPIN(xb_ld(&bar[XB_XGEN(b.x)]) == gen, bar);
            __builtin_amdgcn_fence(__ATOMIC_ACQUIRE, "agent");
            asm volatile("s_waitcnt vmcnt(0)" ::: "memory");
        }
    }
    __syncthreads();
}

constexpr int LDS_RING = 131072, LDS_X = LDS_RING, LDS_BYTES = LDS_RING + 16384;

#define PHASE_IDS() int tid_ = threadIdx.x; asm volatile("" : "+v"(tid_)); const int lane = tid_ & 63, wave = __builtin_amdgcn_readfirstlane(tid_ >> 6); \
    const int gw = bid * NWAVES + wave, NGW = G * NWAVES; LAS float* scr = (LAS float*)(lds + wave * 16384)

__global__ void __launch_bounds__(NTHREADS, 2) fwd_megakernel(Params Pk) {
    extern __shared__ __attribute__((aligned(16))) unsigned char lds_raw[];
    cg::grid_group grid = cg::this_grid();
    LAS unsigned char* lds = (LAS unsigned char*)lds_raw;
    const int G = gridDim.x, bid = blockIdx.x;
#define P (*(const Params*)__builtin_amdgcn_kernarg_segment_ptr())
    volatile LAS unsigned* MISC = (volatile LAS unsigned*)(lds + LDS_X + 4096);
    if (threadIdx.x < 2) MISC[threadIdx.x] = 0u;
    __syncthreads();
    (void)xcd_barrier_post((unsigned*)P.ws, MISC);
#define GRID_BAR() do { XcdBarrier xb_; xb_.bar = (unsigned*)P.ws; xb_.x = xb_xcc_id(); xb_.st = (volatile LAS unsigned*)(lds + LDS_X + 4096); xcd_barrier(xb_); } while (0)
    {
        PHASE_IDS();
        convert_mixer(P, 0, scr, gw, NGW, lane);
        xb0_phase(P.in[0], (bf16_t*)(P.ws + WS_XN), (float*)(P.ws + WS_ROWSS), gw, NGW, lane);
    }
    grid.sync();

    for (int hl = 0; hl < 2 * DEPTH; ++hl) {
        const int L = hl >> 1, j = L >> 1;
        const bool attn = (L & 1) == 0;
        if ((hl & 1) == 0) {
            {
                PHASE_IDS();
                convert_ffn(P, L, scr, gw, NGW, lane);
                __syncthreads();
            }
            {
                unsigned char* ws = P.ws;
                const bf16_t* wv = (const bf16_t*)(ws + WS_WMIX + WM_A) + (size_t)(attn ? QKD : SH) * DM;
                pg8::Gemm g1{(const bf16_t*)(ws + WS_XN), (const bf16_t*)(ws + WS_WMIX + WM_A), DM, wv, (const bf16_t*)(ws + WS_XN)};
                pg8::Order S; S.init(MTOK / 256, attn ? QKD / 256 : SH / 256, G, bid, 0, attn ? KVD / 256 : SH / 256, MTOK / 256);
                EpiG1 E{attn ? 1 : 0, j};
                pg8::gemm_phase(lds, g1, S, E);
            }
            GRID_BAR();
            if (attn) {
                unsigned char* ws = P.ws;
                attn_phase(lds, (const bf16_t*)(ws + WS_BIG), (const bf16_t*)(ws + WS_BIG + 80 * MiB), (bf16_t*)(ws + WS_BIG + 96 * MiB), P.in[3] + j * NH, G, bid);
            } else {
                unsigned char* ws = P.ws;
                spatial_phase(lds, (const bf16_t*)(ws + WS_BIG + 192 * MiB), (bf16_t*)(ws + WS_BIG), (const bf16_t*)(ws + WS_WMIX + WM_S), (const float*)(ws + WS_PSUM), (const float*)(ws + WS_PSQ),
                              P.in[7] + (size_t)j * SH, P.in[8] + (size_t)j * SH, P.in[10] + (size_t)j * NGRP * CHK, G, bid);
            }
            GRID_BAR();
        } else {
            if (L + 1 < DEPTH) {
                PHASE_IDS();
                convert_mixer(P, L + 1, scr, gw, NGW, lane);
                __syncthreads();
            }
            unsigned char* ws = P.ws;
            pg8::Gemm g1{(const bf16_t*)(ws + WS_XN), (const bf16_t*)(ws + WS_WFFN + WF_A), DM, nullptr, nullptr};
            pg8::Order S; S.init(MTOK / 256, 2 * DFF / 256, G, bid, 0);
            EpiConv E{L, (LAS float*)(lds + LDS_X)};
            pg8::gemm_phase(lds, g1, S, E);
            GRID_BAR();
        }
        {
            unsigned char* ws = P.ws;
            pg8::Gemm gy;
            if ((hl & 1) == 0) {
                if (attn) gy = pg8::Gemm{(const bf16_t*)(ws + WS_BIG + 96 * MiB), (const bf16_t*)(ws + WS_WMIX + WM_B), DM, nullptr, nullptr};
                else gy = pg8::Gemm{(const bf16_t*)(ws + WS_BIG), (const bf16_t*)(ws + WS_WMIX + WM_B), SH, nullptr, nullptr};
            } else gy = pg8::Gemm{(const bf16_t*)(ws + WS_BIG), (const bf16_t*)(ws + WS_WFFN + WF_B), DFF, nullptr, nullptr};
            pg8::Order S; S.init(MTOK / 256, DM / 256, G, bid, 0);
            if (hl & 1) {
                int tid_ = threadIdx.x; asm volatile("" : "+v"(tid_));
                pg8::Unit fu;
                for (int i = 0; S.next(i, fu); ++i) ffn_fixup(fu.pm, L, tid_);
                asm volatile("s_waitcnt vmcnt(0)" ::: "memory"); __syncthreads();
            }
            EpiResid E{hl, (LAS float*)(lds + LDS_X + 8192), (LAS float*)(lds + LDS_X + 12288)};
            pg8::gemm_phase(lds, gy, S, E);
        }
        if (hl + 1 < 2 * DEPTH) GRID_BAR();
    }
#undef P
#undef GRID_BAR
}

extern "C" void kernel_launch(void* const* d_in, const int* in_sizes, int n_in, void* d_out, int out_size, void* d_ws, size_t ws_size, hipStream_t stream) {
    static int grid = 0;
    if (grid == 0) {
        if (n_in != 20 || in_sizes[0] != MTOK * DM || out_size != MTOK * DM || ws_size < WS_END) {
            fprintf(stderr, "kernel_launch: unexpected shapes (n_in %d, in0 %d, out %d, ws %zu, need %zu); nothing launched\n", n_in, n_in > 0 ? in_sizes[0] : -1, out_size, ws_size, (size_t)WS_END);
            grid = -1; return; }
        int dev = 0, cus = 0, per_cu = 0;
        hipGetDevice(&dev);
        hipDeviceGetAttribute(&cus, hipDeviceAttributeMultiprocessorCount, dev);
        hipFuncSetAttribute((const void*)fwd_megakernel, hipFuncAttributeMaxDynamicSharedMemorySize, LDS_BYTES);
        hipOccupancyMaxActiveBlocksPerMultiprocessor(&per_cu, (const void*)fwd_megakernel, NTHREADS, LDS_BYTES);
        if (per_cu < 1) per_cu = 1;
        (void)hipGetLastError();
        grid = cus;
    }
    if (grid < 0) return;
    if (hipMemsetAsync(d_ws, 0, 131072, stream) != hipSuccess) { fprintf(stderr, "kernel_launch: memset failed\n"); return; }
    if (hipMemsetAsync((char*)d_ws + WS_SLOT, 0, 1u << 20, stream) != hipSuccess) { fprintf(stderr, "kernel_launch: memset failed\n"); return; }
    Params p{};
    for (int i = 0; i < 20; ++i) p.in[i] = (const float*)d_in[i];
    p.out = (float*)d_out; p.ws = (unsigned char*)d_ws;
    void* args[] = {&p};
    hipError_t e = hipLaunchCooperativeKernel((const void*)fwd_megakernel, dim3(grid), dim3(NTHREADS), args, LDS_BYTES, stream);
    if (e != hipSuccess) fprintf(stderr, "cooperative launch failed: %s (grid %d)\n", hipGetErrorString(e), grid);
}
```

```cpp
#include <hip/hip_runtime.h>
#include <hip/hip_cooperative_groups.h>
#include <cstdio>
#include <cstdint>
namespace cg = cooperative_groups;

#define LAS __attribute__((address_space(3)))
typedef unsigned short bf16_t;
typedef short bf16x8 __attribute__((ext_vector_type(8)));
typedef float f32x4 __attribute__((ext_vector_type(4)));
typedef float f32x2 __attribute__((ext_vector_type(2)));
typedef unsigned u32x4 __attribute__((ext_vector_type(4)));
typedef unsigned u32x2 __attribute__((ext_vector_type(2)));

constexpr int DM = 1024, BATCH = 8, SEQ = 4096, MTOK = BATCH * SEQ, DEPTH = 4;
constexpr int QKV = 1536, QKD = 1280, KVD = 256, NH = 16;
constexpr int SH = 3072, NGRP = 8, GD = 384, CHK = 128;
constexpr int DFF = 2816;
constexpr float EPS = 1e-6f;
constexpr int NWAVES = 8, NTHREADS = 512;
constexpr int FFN_TPS = 17;

constexpr size_t MiB = 1u << 20;
constexpr size_t WS_PSUM = 1 * MiB;
constexpr size_t WS_PSQ = 4 * MiB;
constexpr size_t WS_CNT = 64 * 1024;
constexpr size_t WS_ROWSS = 7 * MiB;
constexpr size_t WS_SLOT = 26 * MiB + 512 * 1024;
constexpr size_t WS_WMIX = 8 * MiB;
constexpr size_t WS_WFFN = 28 * MiB;
constexpr size_t WS_XN = 48 * MiB;
constexpr size_t WS_BIG = 114 * MiB;
constexpr size_t WS_SBG0 = WS_BIG + 180 * MiB, WS_SBU0 = WS_BIG + 183 * MiB, WS_SB1 = WS_BIG + 186 * MiB;
constexpr size_t WS_END = WS_BIG + 384 * MiB;
constexpr size_t WM_A = 0;
constexpr size_t WM_B = 12 * MiB;
constexpr size_t WM_S = 18 * MiB;
constexpr size_t WF_A = 0;
constexpr size_t WF_B = 11 * MiB;

__device__ __forceinline__ unsigned cvt_pk_bf16(float lo, float hi) { unsigned r; asm volatile("v_cvt_pk_bf16_f32 %0, %1, %2" : "=v"(r) : "v"(lo), "v"(hi)); return r; }
__device__ __forceinline__ float bf_lo(unsigned w) { return __uint_as_float(w << 16); }
__device__ __forceinline__ float bf_hi(unsigned w) { return __uint_as_float(w & 0xffff0000u); }
__device__ __forceinline__ float gelu_tanh(float x) {
    const float t = x * (1.0f + 0.044715f * x * x) * (-2.0f * 0.7978845608028654f * 1.4426950408889634f);
    const float e = __builtin_amdgcn_exp2f(t);
    return x * __builtin_amdgcn_rcpf(1.0f + e);
}
__device__ __forceinline__ f32x2 gelu2(f32x2 x) {
    const float KK = -2.0f * 0.7978845608028654f * 1.4426950408889634f;
    const f32x2 p = (x * x) * (0.044715f * KK) + KK, t = x * p;
    f32x2 e; e.x = __builtin_amdgcn_exp2f(t.x); e.y = __builtin_amdgcn_exp2f(t.y);
    const f32x2 d = e + 1.0f;
    f32x2 r; r.x = __builtin_amdgcn_rcpf(d.x); r.y = __builtin_amdgcn_rcpf(d.y);
    return x * r;
}
__device__ __forceinline__ f32x4 gelu4(f32x4 v) { const f32x2 a = gelu2((f32x2){v[0], v[1]}), b = gelu2((f32x2){v[2], v[3]}); return (f32x4){a.x, a.y, b.x, b.y}; }
template <int CTRL> __device__ __forceinline__ float dpp_f(float v) { return __int_as_float(__builtin_amdgcn_update_dpp(0, __float_as_int(v), CTRL, 0xf, 0xf, true)); }
__device__ __forceinline__ float row16_sum(float v) { v += dpp_f<0xB1>(v); v += dpp_f<0x4E>(v); v += dpp_f<0x124>(v); v += dpp_f<0x128>(v); return v; }
__device__ __forceinline__ float wave_sum(float v) {
#pragma unroll
    for (int o = 1; o < 64; o <<= 1) v += __shfl_xor(v, o);
    return v;
}

namespace pg8 {
constexpr int BM = 256, BK = 64, HALF = 128, HTB = HALF * BK * 2, STAGE_BYTES = 8 * HTB, NXCD = 8, WGM = 8;
__host__ __device__ __forceinline__ int lds_byte(int r, int c) { const int st = (r >> 4) * 2 + (c >> 5), rr = r & 15, cc = c & 31, ob = rr * 64 + cc * 2; return st * 1024 + (ob ^ (((ob >> 9) & 1) << 5)); }
__host__ __device__ __forceinline__ void stage_rc(int b, int& R, int& C) { const int st = b / 1024, sb = b % 1024, swz = sb ^ (((sb >> 9) & 1) << 5); R = (st >> 1) * 16 + swz / 64; C = (st & 1) * 32 + (swz % 64) / 2; }
__host__ __device__ __forceinline__ int perm32(int rho) { const int n = rho >> 4, i = rho & 15; return 8 * (i >> 2) + 4 * n + (i & 3); }

struct Unit { int pm, pn, arow, brow, kind; };
struct Gemm { const bf16_t* A; const bf16_t* Bt; int K; const bf16_t* A1; const bf16_t* Bt1; };

struct Order {
    int nM, nN, nwg, G, c, ovl, nM1, nN1, nwg1;
    __device__ __forceinline__ void init(int nM_, int nN_, int G_, int c_, int ovl_, int nM1_ = 0, int nN1_ = 0) { nM = nM_; nN = nN_; nwg = nM * nN; G = G_; c = c_; ovl = ovl_; nM1 = nM1_; nN1 = nN1_; nwg1 = nM1 * nN1; }
    __device__ __forceinline__ static void deal(int wgid, int nwg_, int nM_, int nN_, int& pm, int& pn) {
        { const int q = nwg_ / NXCD, r = nwg_ % NXCD, xcd = wgid % NXCD, off = wgid / NXCD; wgid = (xcd < r ? xcd * (q + 1) : r * (q + 1) + (xcd - r) * q) + off; }
        const int nig = WGM * nN_, gid = wgid / nig, fm = gid * WGM, gsz = (nM_ - fm) < WGM ? (nM_ - fm) : WGM;
        pm = fm + ((wgid % nig) % gsz); pn = (wgid % nig) / gsz;
    }
    __device__ __forceinline__ bool next(int i, Unit& u) const {
        const long L = (long)i * G + c; if (L >= nwg + nwg1) return false;
        if (L < nwg) { deal((int)L, nwg, nM, nN, u.pm, u.pn); u.kind = 0; }
        else { deal((int)L - nwg, nwg1, nM1, nN1, u.pm, u.pn); u.kind = 1; }
        u.arow = u.pm * BM;
        u.brow = u.pn * BM;
        return true;
    }
};

template <class Epi>
__device__ __forceinline__ void gemm_phase(LAS unsigned char* lds, const Gemm g, const Order& S, Epi& E) {
    int tid = threadIdx.x; asm volatile("" : "+v"(tid));
    const int wid = __builtin_amdgcn_readfirstlane(tid >> 6), lane = tid & 63, wr = wid >> 2, wc = wid & 3, fr = lane & 15, fq = lane >> 4;
    const int K = g.K, nt = K / BK;
    unsigned voffA[2], voffB[2];
#pragma unroll
    for (int i = 0; i < 2; ++i) { int R, C; stage_rc(tid * 16 + i * 8192, R, C); const int Rb = (R & ~31) + perm32(R & 31);
        voffA[i] = (unsigned)(R * K + C) * 2u; voffB[i] = (unsigned)(Rb * K + C) * 2u; }
    const size_t kstep = (size_t)(BK * 2);
    const size_t hstep = (size_t)HALF * K * 2;
    const long rowb = (long)K * 2;
    const unsigned ldsw = (unsigned)wid * 1024u;
    const int aoff = lds_byte(wr * 64 + fr, fq * 8), boff = lds_byte(wc * 32 + fr, fq * 8);
#define PG8_SA(b, h) (((b) * 2 + (h)) * HTB)
#define PG8_SB(b, h) ((4 + (b) * 2 + (h)) * HTB)
#define PG8_STAGE(bufoff, gbase, voff) do { _Pragma("unroll") for (int _i = 0; _i < 2; ++_i) \
        __builtin_amdgcn_global_load_lds((const unsigned*)((const char*)(gbase) + (voff)[_i]), (LAS unsigned*)(lds + (bufoff) + ldsw + _i * 8192), 16, 0, 0); } while (0)
#define PG8_LDA(dst, b, h) do { _Pragma("unroll") for (int m = 0; m < 4; ++m) _Pragma("unroll") for (int k = 0; k < 2; ++k) dst[m][k] = *(const LAS bf16x8*)(lds + PG8_SA(b, h) + aoff + m * 2048 + k * 1024); } while (0)
#define PG8_LDB(dst, b, h) do { _Pragma("unroll") for (int n = 0; n < 2; ++n) _Pragma("unroll") for (int k = 0; k < 2; ++k) dst[n][k] = *(const LAS bf16x8*)(lds + PG8_SB(b, h) + boff + n * 2048 + k * 1024); } while (0)
#define PG8_MMA(ai, bj, At, Bt) do { __builtin_amdgcn_s_setprio(1); _Pragma("unroll") for (int m = 0; m < 4; ++m) _Pragma("unroll") for (int n = 0; n < 2; ++n) _Pragma("unroll") for (int k = 0; k < 2; ++k) \
        acc[ai][bj][m][n] = __builtin_amdgcn_mfma_f32_16x16x32_bf16(Bt[n][k], At[m][k], acc[ai][bj][m][n], 0, 0, 0); __builtin_amdgcn_s_setprio(0); } while (0)
#define PG8_WAIT_V(n) asm volatile("s_waitcnt vmcnt(" #n ")" ::: "memory")
#define PG8_WAIT_L(n) asm volatile("s_waitcnt lgkmcnt(" #n ")" ::: "memory")
#define PG8_BAR __builtin_amdgcn_s_barrier()
#define PG8_SCHED __builtin_amdgcn_sched_barrier(0)
    Unit cur, nxt; int ui = 0;
    if (!S.next(0, cur)) return;
    float zf = 0.f; asm volatile("" : "+v"(zf));
    f32x4 acc[2][2][4][2];
#pragma unroll
    for (int a = 0; a < 2; ++a)
#pragma unroll
        for (int b = 0; b < 2; ++b)
#pragma unroll
            for (int m = 0; m < 4; ++m)
#pragma unroll
                for (int n = 0; n < 2; ++n) acc[a][b][m][n] = (f32x4){zf, zf, zf, zf};
    bf16x8 At[4][2], B0[2][2], B1[2][2];
    const char* cA = (const char*)(cur.kind ? g.A1 : g.A) + (long)cur.arow * rowb; const char* cB = (const char*)(cur.kind ? g.Bt1 : g.Bt) + (long)cur.brow * rowb;
    PG8_STAGE(PG8_SB(0, 0), cB, voffB); PG8_STAGE(PG8_SB(0, 1), cB + hstep, voffB); PG8_STAGE(PG8_SA(0, 0), cA, voffA); PG8_STAGE(PG8_SA(0, 1), cA + hstep, voffA);
    if (wr == 1) PG8_BAR;
    PG8_WAIT_V(2); PG8_BAR;
    PG8_STAGE(PG8_SB(1, 0), cB + kstep, voffB); PG8_STAGE(PG8_SA(1, 0), cA + kstep, voffA); PG8_STAGE(PG8_SB(1, 1), cB + hstep + kstep, voffB);
    PG8_WAIT_V(6); PG8_BAR;
    for (;;) {
        const bool has_next = S.next(ui + 1, nxt);
        const char* nA = has_next ? (const char*)(nxt.kind ? g.A1 : g.A) + (long)nxt.arow * rowb : cA; const char* nB = has_next ? (const char*)(nxt.kind ? g.Bt1 : g.Bt) + (long)nxt.brow * rowb : cB;
        for (int t = 0; t < nt; t += 2) {
            const bool last = (t == nt - 2);
            const char* a1 = cA + (size_t)(t + 1) * kstep;
            const char* a2 = last ? nA : cA + (size_t)(t + 2) * kstep; const char* b2 = last ? nB : cB + (size_t)(t + 2) * kstep;
            const char* a3 = a2 + kstep; const char* b3 = b2 + kstep;
            PG8_LDB(B0, 0, 0); PG8_LDB(B1, 0, 1); PG8_SCHED; PG8_LDA(At, 0, 0); PG8_STAGE(PG8_SA(1, 1), a1 + hstep, voffA);
            PG8_WAIT_V(8); PG8_WAIT_L(0); PG8_BAR; PG8_MMA(0, 0, At, B0); PG8_MMA(0, 1, At, B1); PG8_BAR; PG8_SCHED;
            PG8_LDA(At, 0, 1); PG8_STAGE(PG8_SB(0, 0), b2, voffB); PG8_STAGE(PG8_SB(0, 1), b2 + hstep, voffB); PG8_STAGE(PG8_SA(0, 0), a2, voffA);
            PG8_WAIT_V(8); PG8_WAIT_L(0); PG8_BAR; PG8_MMA(1, 0, At, B0); PG8_MMA(1, 1, At, B1); PG8_BAR; PG8_SCHED;
            PG8_LDB(B0, 1, 0); PG8_LDB(B1, 1, 1); PG8_SCHED; PG8_LDA(At, 1, 0); PG8_STAGE(PG8_SA(0, 1), a2 + hstep, voffA);
            PG8_WAIT_V(8); PG8_WAIT_L(0); PG8_BAR; PG8_MMA(0, 0, At, B0); PG8_MMA(0, 1, At, B1); PG8_BAR; PG8_SCHED;
            PG8_LDA(At, 1, 1); PG8_STAGE(PG8_SB(1, 0), b3, voffB); PG8_STAGE(PG8_SB(1, 1), b3 + hstep, voffB); PG8_STAGE(PG8_SA(1, 0), a3, voffA);
            PG8_WAIT_V(8); PG8_WAIT_L(0); PG8_BAR; PG8_MMA(1, 0, At, B0); PG8_MMA(1, 1, At, B1); PG8_BAR; PG8_SCHED;
        }
        if (wr == 0) PG8_BAR;
        E(acc, cur, wr, wc, fr, fq, lane);
        if (!has_next) break;
#pragma unroll
        for (int a = 0; a < 2; ++a)
#pragma unroll
            for (int b = 0; b < 2; ++b)
#pragma unroll
                for (int m = 0; m < 4; ++m)
#pragma unroll
                    for (int n = 0; n < 2; ++n) acc[a][b][m][n] = (f32x4){zf, zf, zf, zf};
        cur = nxt; cA = nA; cB = nB; ++ui;
        if (wr == 1) PG8_BAR;
    }
    PG8_WAIT_V(0);
    PG8_BAR;
#undef PG8_SA
#undef PG8_SB
#undef PG8_STAGE
#undef PG8_LDA
#undef PG8_LDB
#undef PG8_MMA
#undef PG8_WAIT_V
#undef PG8_WAIT_L
#undef PG8_BAR
#undef PG8_SCHED
}
}

struct Params { const float* in[20]; float* out; unsigned char* ws; };
#define KP (*(const Params*)__builtin_amdgcn_kernarg_segment_ptr())
__device__ __forceinline__ float rstd_of(const float* rowss, int row) { const f32x4 p = *(const f32x4*)(rowss + (size_t)row * 4); return __builtin_amdgcn_rsqf(((p[0] + p[1]) + (p[2] + p[3])) * (1.f / DM) + EPS); }
struct EpiStore {
    int attn, j;
    __device__ __forceinline__ void operator()(f32x4 (&acc)[2][2][4][2], const pg8::Unit& u, int wr, int wc, int fr, int fq, int lane) const {
        unsigned char* ws = KP.ws;
        bf16_t* O = (bf16_t*)(ws + WS_BIG); const long ldc = attn ? (long)QKD : (long)SH; const float* cbias = attn ? KP.in[2] + (size_t)j * QKV : nullptr; const int act = attn ? 0 : 1;
        const float* rowss = (const float*)(ws + WS_ROWSS);
        const int row0 = u.pm * 256 + wr * 64 + fr, col0 = u.pn * 256 + wc * 32 + 8 * fq;
        float rs[2][4];
#pragma unroll
        for (int ai = 0; ai < 2; ++ai)
#pragma unroll
            for (int m = 0; m < 4; ++m) rs[ai][m] = rstd_of(rowss, row0 + ai * 128 + m * 16);
        f32x4 bv[2][2];
#pragma unroll
        for (int bj = 0; bj < 2; ++bj)
#pragma unroll
            for (int n = 0; n < 2; ++n) bv[bj][n] = cbias ? *(const f32x4*)(cbias + col0 + bj * 128 + 4 * n) : (f32x4){0.f, 0.f, 0.f, 0.f};
#pragma unroll
        for (int ai = 0; ai < 2; ++ai)
#pragma unroll
            for (int m = 0; m < 4; ++m) { bf16_t* rowp = O + (size_t)(row0 + ai * 128 + m * 16) * ldc + col0;
#pragma unroll
                for (int bj = 0; bj < 2; ++bj) { f32x4 v0 = acc[ai][bj][m][0] * rs[ai][m] + bv[bj][0], v1 = acc[ai][bj][m][1] * rs[ai][m] + bv[bj][1];
                    if (act) { v0 = gelu4(v0); v1 = gelu4(v1); }
                    u32x4 w; w.x = cvt_pk_bf16(v0[0], v0[1]); w.y = cvt_pk_bf16(v0[2], v0[3]); w.z = cvt_pk_bf16(v1[0], v1[1]); w.w = cvt_pk_bf16(v1[2], v1[3]);
                    *(u32x4*)(rowp + bj * 128) = w; } }
    }
};
struct EpiVT {
    int attn, j;
    __device__ __forceinline__ void operator()(f32x4 (&acc)[2][2][4][2], const pg8::Unit& u, int wr, int wc, int fr, int fq, int lane) const {
        unsigned char* ws = KP.ws;
        bf16_t* O = (bf16_t*)(ws + WS_BIG + (attn ? 80 : 192) * MiB); const float* rbias = attn ? KP.in[2] + (size_t)j * QKV + QKD : nullptr; const int act = attn ? 0 : 1;
        float* psum = attn ? nullptr : (float*)(ws + WS_PSUM); float* psq = attn ? nullptr : (float*)(ws + WS_PSQ); const float* rowss = (const float*)(ws + WS_ROWSS);
        const int row0 = u.pm * 256 + wr * 64 + fr, col0 = u.pn * 256 + wc * 32 + 8 * fq;
#pragma unroll
        for (int bj = 0; bj < 2; ++bj) {
            f32x4 c0, c1v;
#pragma unroll
            for (int i = 0; i < 4; ++i) { c0[i] = rstd_of(rowss, col0 + bj * 128 + i); c1v[i] = rstd_of(rowss, col0 + bj * 128 + 4 + i); }
            f32x4 s0 = (f32x4){0.f, 0.f, 0.f, 0.f}, s1 = s0, q0 = s0, q1 = s0;
#pragma unroll
            for (int ai = 0; ai < 2; ++ai)
#pragma unroll
                for (int m = 0; m < 4; ++m) { const int row = row0 + ai * 128 + m * 16; const float rb = rbias ? rbias[row] : 0.f;
                    f32x4 v0 = acc[ai][bj][m][0] * c0 + rb, v1 = acc[ai][bj][m][1] * c1v + rb;
                    if (act) { v0 = gelu4(v0); v1 = gelu4(v1); }
                    s0 += v0; s1 += v1; q0 += v0 * v0; q1 += v1 * v1;
                    u32x4 w; w.x = cvt_pk_bf16(v0[0], v0[1]); w.y = cvt_pk_bf16(v0[2], v0[3]); w.z = cvt_pk_bf16(v1[0], v1[1]); w.w = cvt_pk_bf16(v1[2], v1[3]);
                    *(u32x4*)(O + (size_t)row * MTOK + col0 + bj * 128) = w; }
            if (psum) {
#pragma unroll
                for (int i = 0; i < 4; ++i) { s0[i] = row16_sum(s0[i]); s1[i] = row16_sum(s1[i]); q0[i] = row16_sum(q0[i]); q1[i] = row16_sum(q1[i]); }
                if (fr == 0) { const size_t p = (size_t)(u.pm * 2 + wr) * MTOK + col0 + bj * 128;
                    *(f32x4*)(psum + p) = s0; *(f32x4*)(psum + p + 4) = s1; *(f32x4*)(psq + p) = q0; *(f32x4*)(psq + p + 4) = q1; }
            }
        }
    }
};
struct EpiG1 {
    int attn, j;
    __device__ __forceinline__ void operator()(f32x4 (&acc)[2][2][4][2], const pg8::Unit& u, int wr, int wc, int fr, int fq, int lane) const {
        if (u.kind == 0) { EpiStore e{attn, j}; e(acc, u, wr, wc, fr, fq, lane); } else { EpiVT e{attn, j}; e(acc, u, wr, wc, fr, fq, lane); }
    }
};
struct EpiConv {
    int L; LAS float* X;
    __device__ __forceinline__ void operator()(f32x4 (&acc)[2][2][4][2], const pg8::Unit& u, int wr, int wc, int fr, int fq, int lane) const {
        unsigned char* ws = KP.ws;
        bf16_t* O = (bf16_t*)(ws + WS_BIG); const float* cw = KP.in[13] + (size_t)L * 3 * DFF; const float* cb = KP.in[14] + (size_t)L * DFF; const float* rowss = (const float*)(ws + WS_ROWSS);
        const bool seq_start = (u.pm & 15) == 0;
#pragma unroll
        for (int ai = 0; ai < 2; ++ai)
#pragma unroll
            for (int m = 0; m < 4; ++m) { const float r = rstd_of(rowss, u.pm * 256 + ai * 128 + wr * 64 + m * 16 + fr);
#pragma unroll
                for (int bj = 0; bj < 2; ++bj)
#pragma unroll
                    for (int n = 0; n < 2; ++n) acc[ai][bj][m][n] *= r; }
        const int cl = wc * 32 + 8 * fq;
        const int f0 = u.pn * 128 + cl;
        if (fr >= 14) {
#pragma unroll
            for (int ai = 0; ai < 2; ++ai)
#pragma unroll
                for (int n = 0; n < 2; ++n) *(LAS f32x4*)(X + ((ai * 2 + wr) * 2 + (fr - 14)) * 128 + cl + 4 * n) = acc[ai][0][3][n];
            if (wr == 1) {
                float* sb1 = (float*)(ws + WS_SB1) + (size_t)(u.pm * 2 + (fr - 14)) * DFF + f0;
#pragma unroll
                for (int n = 0; n < 2; ++n) *(f32x4*)(sb1 + 4 * n) = acc[1][0][3][n];
            }
        }
        if (wr == 0 && fr < 2 && !seq_start) {
            float* sg = (float*)(ws + WS_SBG0) + (size_t)(u.pm * 2 + fr) * DFF + f0; float* su = (float*)(ws + WS_SBU0) + (size_t)(u.pm * 2 + fr) * DFF + f0;
#pragma unroll
            for (int n = 0; n < 2; ++n) { *(f32x4*)(sg + 4 * n) = acc[0][0][0][n]; *(f32x4*)(su + 4 * n) = acc[0][1][0][n]; }
        }
        asm volatile("s_waitcnt lgkmcnt(0)" ::: "memory"); __builtin_amdgcn_s_barrier(); asm volatile("" ::: "memory");
        u32x2 hp[2][4];
#pragma unroll
        for (int n = 0; n < 2; ++n) {
            const f32x4 w0 = *(const f32x4*)(cw + f0 + 4 * n), w1 = *(const f32x4*)(cw + DFF + f0 + 4 * n), w2 = *(const f32x4*)(cw + 2 * DFF + f0 + 4 * n), wb = *(const f32x4*)(cb + f0 + 4 * n);
#pragma unroll
            for (int ai = 0; ai < 2; ++ai) {
                const int blk = ai * 2 + wr;
                f32x4 pr1 = (f32x4){0.f, 0.f, 0.f, 0.f}, pr2 = pr1;
                if (blk > 0 && fr < 2) { pr2 = *(const LAS f32x4*)(X + ((blk - 1) * 2 + fr) * 128 + cl + 4 * n); pr1 = *(const LAS f32x4*)(X + ((blk - 1) * 2 + 1) * 128 + cl + 4 * n); }
#pragma unroll
                for (int m = 0; m < 4; ++m) {
                    const int lr = ai * 128 + wr * 64 + m * 16 + fr;
                    const f32x4 cur = acc[ai][0][m][n];
                    f32x4 r1, r2;
#pragma unroll
                    for (int i = 0; i < 4; ++i) { r1[i] = dpp_f<0x121>(cur[i]); r2[i] = dpp_f<0x122>(cur[i]); }
                    const f32x4 p1 = (fr >= 1) ? r1 : pr1, p2 = (fr >= 2) ? r2 : pr2;
                    pr1 = r1; pr2 = r2;
                    const f32x4 gc = wb + w0 * p2 + w1 * p1 + w2 * cur;
                    const f32x4 hv = gelu4(gc) * acc[ai][1][m][n];
                    u32x2 w; w.x = cvt_pk_bf16(hv[0], hv[1]); w.y = cvt_pk_bf16(hv[2], hv[3]);
                    if (n == 0) hp[ai][m] = w;
                    else if (lr >= 2 || seq_start) *(u32x4*)(O + (size_t)(u.pm * 256 + lr) * DFF + f0) = (u32x4){hp[ai][m].x, hp[ai][m].y, w.x, w.y};
                }
            }
        }
    }
};
__device__ __forceinline__ void ffn_fixup(int pm, int L, int tid) {
    if ((pm & 15) == 0) return;
    unsigned char* ws = KP.ws;
    const float* sg0 = (const float*)(ws + WS_SBG0) + (size_t)pm * 2 * DFF; const float* su0 = (const float*)(ws + WS_SBU0) + (size_t)pm * 2 * DFF; const float* sp = (const float*)(ws + WS_SB1) + (size_t)(pm - 1) * 2 * DFF;
    const float* cw = KP.in[13] + (size_t)L * 3 * DFF; const float* cb = KP.in[14] + (size_t)L * DFF; bf16_t* O = (bf16_t*)(ws + WS_BIG);
    for (int idx = tid; idx < 2 * (DFF / 4); idx += NTHREADS) {
        const int lr = idx / (DFF / 4), f = 4 * (idx % (DFF / 4));
        const f32x4 cur = *(const f32x4*)(sg0 + lr * DFF + f), uu = *(const f32x4*)(su0 + lr * DFF + f);
        const f32x4 p1 = lr == 0 ? *(const f32x4*)(sp + DFF + f) : *(const f32x4*)(sg0 + f);
        const f32x4 p2 = lr == 0 ? *(const f32x4*)(sp + f) : *(const f32x4*)(sp + DFF + f);
        const f32x4 gc = *(const f32x4*)(cb + f) + *(const f32x4*)(cw + f) * p2 + *(const f32x4*)(cw + DFF + f) * p1 + *(const f32x4*)(cw + 2 * DFF + f) * cur;
        const f32x4 hv = gelu4(gc) * uu;
        u32x2 w; w.x = cvt_pk_bf16(hv[0], hv[1]); w.y = cvt_pk_bf16(hv[2], hv[3]);
        *(u32x2*)(O + (size_t)(pm * 256 + lr) * DFF + f) = w;
    }
}
struct EpiResid {
    int hl; LAS float* Pt; LAS float* St;
    __device__ __forceinline__ void operator()(f32x4 (&acc)[2][2][4][2], const pg8::Unit& u, int wr, int wc, int fr, int fq, int lane) const {
        unsigned char* ws = KP.ws; const int L = hl >> 1;
        bf16_t* XB = (bf16_t*)(ws + WS_XN); float* OUT = (hl + 1 == 2 * DEPTH) ? KP.out : nullptr;
        const float* cbias = (hl & 3) == 0 ? KP.in[5] + (size_t)(L >> 1) * DM : nullptr;
        const float* gpost = ((hl & 1) == 0 ? KP.in[17] : KP.in[19]) + (size_t)L * DM;
        unsigned long long* slots = (unsigned long long*)(ws + WS_SLOT); const unsigned tag = (unsigned)(hl + 1); float* rowss = (float*)(ws + WS_ROWSS);
        const int wid = wr * 4 + wc, tid = wid * 64 + lane;
        const int row0 = u.pm * 256 + wr * 64 + fr, col0 = u.pn * 256 + wc * 32 + 8 * fq;
        if (cbias) {
#pragma unroll
            for (int bj = 0; bj < 2; ++bj)
#pragma unroll
                for (int n = 0; n < 2; ++n) { const f32x4 bv = *(const f32x4*)(cbias + col0 + bj * 128 + 4 * n);
#pragma unroll
                    for (int ai = 0; ai < 2; ++ai)
#pragma unroll
                        for (int m = 0; m < 4; ++m) acc[ai][bj][m][n] += bv; }
        }
#pragma unroll
        for (int ai = 0; ai < 2; ++ai)
#pragma unroll
            for (int m = 0; m < 4; ++m) { float sq = 0.f;
#pragma unroll
                for (int bj = 0; bj < 2; ++bj)
#pragma unroll
                    for (int n = 0; n < 2; ++n) { const f32x4 v = acc[ai][bj][m][n]; sq += (v[0] * v[0] + v[1] * v[1]) + (v[2] * v[2] + v[3] * v[3]); }
                sq += __shfl_xor(sq, 16); sq += __shfl_xor(sq, 32);
                if (fq == 0) Pt[(ai * 128 + wr * 64 + m * 16 + fr) * 4 + wc] = sq; }
        asm volatile("s_waitcnt lgkmcnt(0)" ::: "memory"); __builtin_amdgcn_s_barrier(); asm volatile("" ::: "memory");
        if (tid < 256) {
            const f32x4 p = *(const LAS f32x4*)(Pt + tid * 4);
            __hip_atomic_store(slots + (size_t)(u.pm * 256 + tid) * 4 + u.pn, ((unsigned long long)tag << 32) | (unsigned long long)__float_as_uint((p[0] + p[1]) + (p[2] + p[3])), __ATOMIC_RELAXED, __HIP_MEMORY_SCOPE_AGENT);
        }
        asm volatile("" ::: "memory");
        u32x4 xr[4][2];
#pragma unroll
        for (int m = 0; m < 4; ++m)
#pragma unroll
            for (int bj = 0; bj < 2; ++bj) xr[m][bj] = *(const u32x4*)(XB + (size_t)(row0 + m * 16) * DM + col0 + bj * 128);
        f32x4 gp[2][2];
#pragma unroll
        for (int bj = 0; bj < 2; ++bj)
#pragma unroll
            for (int n = 0; n < 2; ++n) gp[bj][n] = *(const f32x4*)(gpost + col0 + bj * 128 + 4 * n);
        if (tid < 256) {
            const unsigned long long* sl = slots + (size_t)(u.pm * 256 + tid) * 4; float t = 0.f; unsigned sp = 0;
            for (;;) {
                const unsigned long long a0 = __hip_atomic_load(sl + 0, __ATOMIC_RELAXED, __HIP_MEMORY_SCOPE_AGENT), a1 = __hip_atomic_load(sl + 1, __ATOMIC_RELAXED, __HIP_MEMORY_SCOPE_AGENT),
                                         a2 = __hip_atomic_load(sl + 2, __ATOMIC_RELAXED, __HIP_MEMORY_SCOPE_AGENT), a3 = __hip_atomic_load(sl + 3, __ATOMIC_RELAXED, __HIP_MEMORY_SCOPE_AGENT);
                const bool ok = ((unsigned)(a0 >> 32) == tag) && ((unsigned)(a1 >> 32) == tag) && ((unsigned)(a2 >> 32) == tag) && ((unsigned)(a3 >> 32) == tag);
                t = (__uint_as_float((unsigned)a0) + __uint_as_float((unsigned)a1)) + (__uint_as_float((unsigned)a2) + __uint_as_float((unsigned)a3));
                if (__builtin_amdgcn_ballot_w64(!ok) == 0ull || ++sp > (1u << 22)) break;
                __builtin_amdgcn_s_sleep(1);
            }
            St[tid] = __builtin_amdgcn_rsqf(t * (1.f / DM) + EPS);
        }
        asm volatile("s_waitcnt lgkmcnt(0)" ::: "memory"); __builtin_amdgcn_s_barrier(); asm volatile("" ::: "memory");
#pragma unroll
        for (int ai = 0; ai < 2; ++ai) {
            if (ai == 1) {
                asm volatile("" ::: "memory");
#pragma unroll
                for (int m = 0; m < 4; ++m)
#pragma unroll
                    for (int bj = 0; bj < 2; ++bj) xr[m][bj] = *(const u32x4*)(XB + (size_t)(row0 + 128 + m * 16) * DM + col0 + bj * 128);
            }
#pragma unroll
            for (int m = 0; m < 4; ++m) { const int lr = ai * 128 + wr * 64 + m * 16 + fr; const float r = St[lr]; float sq = 0.f;
                const size_t off = (size_t)(u.pm * 256 + lr) * DM + col0;
#pragma unroll
                for (int bj = 0; bj < 2; ++bj) { const u32x4 xw = xr[m][bj];
                    const f32x4 x0 = (f32x4){bf_lo(xw.x), bf_hi(xw.x), bf_lo(xw.y), bf_hi(xw.y)}, x1 = (f32x4){bf_lo(xw.z), bf_hi(xw.z), bf_lo(xw.w), bf_hi(xw.w)};
                    const f32x4 o0 = x0 + acc[ai][bj][m][0] * r * gp[bj][0], o1 = x1 + acc[ai][bj][m][1] * r * gp[bj][1];
                    sq += ((o0[0] * o0[0] + o0[1] * o0[1]) + (o0[2] * o0[2] + o0[3] * o0[3])) + ((o1[0] * o1[0] + o1[1] * o1[1]) + (o1[2] * o1[2] + o1[3] * o1[3]));
                    if (OUT) { *(f32x4*)(OUT + off + bj * 128) = o0; *(f32x4*)(OUT + off + bj * 128 + 4) = o1; }
                    else { u32x4 w; w.x = cvt_pk_bf16(o0[0], o0[1]); w.y = cvt_pk_bf16(o0[2], o0[3]); w.z = cvt_pk_bf16(o1[0], o1[1]); w.w = cvt_pk_bf16(o1[2], o1[3]); *(u32x4*)(XB + off + bj * 128) = w; } }
                sq += __shfl_xor(sq, 16); sq += __shfl_xor(sq, 32);
                if (fq == 0) Pt[lr * 4 + wc] = sq; }
        }
        asm volatile("s_waitcnt lgkmcnt(0)" ::: "memory"); __builtin_amdgcn_s_barrier(); asm volatile("" ::: "memory");
        if (tid < 256) { const f32x4 p = *(const LAS f32x4*)(Pt + tid * 4); rowss[(size_t)(u.pm * 256 + tid) * 4 + u.pn] = (p[0] + p[1]) + (p[2] + p[3]); }
    }
};

struct ConvSrc { const float* W; int K, N; bf16_t* WT; int mode; const float* gk; };
__device__ __forceinline__ void conv_load(const ConvSrc& c, int item, int lane, float (&R)[32]) {
    const int nblk = c.N / 32, kb = item / nblk, nb = item % nblk, k0 = 64 * kb, n0 = 32 * nb;
#pragma unroll
    for (int i = 0; i < 32; ++i) { const int kk = 2 * i + (lane >> 5); const float gv = c.gk ? c.gk[k0 + kk] : 1.f; R[i] = c.W[(size_t)(k0 + kk) * c.N + n0 + (lane & 31)] * gv; }
}
__device__ __forceinline__ void conv_store(const ConvSrc& c, int item, int lane, LAS float* scr, const float (&R)[32]) {
    const int nblk = c.N / 32, kb = item / nblk, nb = item % nblk, k0 = 64 * kb, n0 = 32 * nb;
#pragma unroll
    for (int i = 0; i < 32; ++i) scr[(2 * i + (lane >> 5)) * 33 + (lane & 31)] = R[i];
}
__device__ __forceinline__ void conv_finish(const ConvSrc& c, int item, int lane, LAS float* scr) {
    const int nblk = c.N / 32, kb = item / nblk, nb = item % nblk, k0 = 64 * kb, n0 = 32 * nb;
    asm volatile("s_waitcnt lgkmcnt(0)" ::: "memory");
    int d0 = n0;
    if (c.mode == 1) { const int f = (n0 < DFF) ? n0 : n0 - DFF; d0 = 256 * (f >> 7) + (f & 127) + ((n0 < DFF) ? 0 : 128); }
    const int cc = lane & 7;
#pragma unroll
    for (int j = 0; j < 4; ++j) { const int n = (lane >> 3) + 8 * j; const LAS float* sp = scr + (8 * cc) * 33 + n;
        u32x4 o; o.x = cvt_pk_bf16(sp[0 * 33], sp[1 * 33]); o.y = cvt_pk_bf16(sp[2 * 33], sp[3 * 33]); o.z = cvt_pk_bf16(sp[4 * 33], sp[5 * 33]); o.w = cvt_pk_bf16(sp[6 * 33], sp[7 * 33]);
        *(u32x4*)(c.WT + (size_t)(d0 + n) * c.K + k0 + 8 * cc) = o; }
    asm volatile("s_waitcnt lgkmcnt(0)" ::: "memory");
}
__device__ __forceinline__ ConvSrc conv_pick(const ConvSrc a, const ConvSrc b, bool first) {
    ConvSrc c; c.W = first ? a.W : b.W; c.K = first ? a.K : b.K; c.N = first ? a.N : b.N; c.WT = first ? a.WT : b.WT; c.mode = first ? a.mode : b.mode; c.gk = first ? a.gk : b.gk; return c;
}
__device__ __forceinline__ void convert_pair(const ConvSrc a, int I1, const ConvSrc b, int I2, LAS float* scr, int gw, int NGW, int lane) {
    float R[32];
    int it = gw;
    if (it < I1 + I2) { const ConvSrc c = conv_pick(a, b, it < I1); conv_load(c, it < I1 ? it : it - I1, lane, R); }
    while (it < I1 + I2) {
        const int nx = it + NGW;
        const ConvSrc c = conv_pick(a, b, it < I1); const int ci = it < I1 ? it : it - I1;
        conv_store(c, ci, lane, scr, R);
        if (nx < I1 + I2) { const ConvSrc cn = conv_pick(a, b, nx < I1); conv_load(cn, nx < I1 ? nx : nx - I1, lane, R); }
        conv_finish(c, ci, lane, scr);
        it = nx;
    }
}

__device__ __forceinline__ void convert_mixer(const Params& P, int L, LAS float* scr, int gw, int NGW, int lane) {
    const int j = L >> 1;
    unsigned char* wm = P.ws + WS_WMIX;
    if ((L & 1) == 0) {
        const ConvSrc a{P.in[1] + (size_t)j * DM * QKV, DM, QKV, (bf16_t*)(wm + WM_A), 0, P.in[16] + (size_t)L * DM};
        const ConvSrc b{P.in[4] + (size_t)j * DM * DM, DM, DM, (bf16_t*)(wm + WM_B), 0, nullptr};
        convert_pair(a, (DM / 64) * (QKV / 32), b, (DM / 64) * (DM / 32), scr, gw, NGW, lane);
    } else {
        const ConvSrc a{P.in[6] + (size_t)j * DM * 2 * SH, DM, 2 * SH, (bf16_t*)(wm + WM_A), 0, P.in[16] + (size_t)L * DM};
        const ConvSrc b{P.in[11] + (size_t)j * SH * DM, SH, DM, (bf16_t*)(wm + WM_B), 0, nullptr};
        convert_pair(a, (DM / 64) * (2 * SH / 32), b, (SH / 64) * (DM / 32), scr, gw, NGW, lane);
        const float* wsp = P.in[9] + (size_t)j * NGRP * CHK * CHK;
        bf16_t* wsb = (bf16_t*)(wm + WM_S);
        for (int e = (gw * 64 + lane) * 4; e < NGRP * CHK * CHK; e += NGW * 64 * 4) {
            const f32x4 v = *(const f32x4*)(wsp + e); const int t = (e >> 7) & 127, s0 = e & 127;
            u32x2 o; o.x = cvt_pk_bf16(s0 <= t ? v[0] : 0.f, s0 + 1 <= t ? v[1] : 0.f); o.y = cvt_pk_bf16(s0 + 2 <= t ? v[2] : 0.f, s0 + 3 <= t ? v[3] : 0.f);
            *(u32x2*)(wsb + e) = o;
        }
    }
}
__device__ __forceinline__ void convert_ffn(const Params& P, int L, LAS float* scr, int gw, int NGW, int lane) {
    unsigned char* wf = P.ws + WS_WFFN;
    const ConvSrc a{P.in[12] + (size_t)L * DM * 2 * DFF, DM, 2 * DFF, (bf16_t*)(wf + WF_A), 1, P.in[18] + (size_t)L * DM};
    const ConvSrc b{P.in[15] + (size_t)L * DFF * DM, DFF, DM, (bf16_t*)(wf + WF_B), 0, nullptr};
    convert_pair(a, (DM / 64) * (2 * DFF / 32), b, (DFF / 64) * (DM / 32), scr, gw, NGW, lane);
}

__device__ __forceinline__ void xb0_phase(const float* x, bf16_t* xb, float* rowss, int gw, int NGW, int lane) {
    for (int r = gw; r < MTOK; r += 2 * NGW) {
        f32x4 v[2][4];
#pragma unroll
        for (int k = 0; k < 2; ++k)
#pragma unroll
            for (int j = 0; j < 2; ++j) { const float* p = x + (size_t)(r + k * NGW) * DM + 8 * lane + 512 * j;
                v[k][2 * j] = __builtin_nontemporal_load((const f32x4*)p); v[k][2 * j + 1] = __builtin_nontemporal_load((const f32x4*)(p + 4)); }
#pragma unroll
        for (int k = 0; k < 2; ++k) {
            float ss = 0.f;
#pragma unroll
            for (int j = 0; j < 4; ++j) ss += (v[k][j][0] * v[k][j][0] + v[k][j][1] * v[k][j][1]) + (v[k][j][2] * v[k][j][2] + v[k][j][3] * v[k][j][3]);
            ss = wave_sum(ss);
            bf16_t* o = xb + (size_t)(r + k * NGW) * DM + 8 * lane;
#pragma unroll
            for (int j = 0; j < 2; ++j) { u32x4 w; w.x = cvt_pk_bf16(v[k][2 * j][0], v[k][2 * j][1]); w.y = cvt_pk_bf16(v[k][2 * j][2], v[k][2 * j][3]);
                w.z = cvt_pk_bf16(v[k][2 * j + 1][0], v[k][2 * j + 1][1]); w.w = cvt_pk_bf16(v[k][2 * j + 1][2], v[k][2 * j + 1][3]); *(u32x4*)(o + 512 * j) = w; }
            if (lane == 0) *(f32x4*)(rowss + (size_t)(r + k * NGW) * 4) = (f32x4){ss, 0.f, 0.f, 0.f};
        }
    }
}

__device__ __forceinline__ void attn_phase(LAS unsigned char* lds, const bf16_t* QK, const bf16_t* VT, bf16_t* O, const float* sinks, int G, int bid) {
    constexpr int LDK = 72, LDV = 280;
    LAS bf16_t* Ks = (LAS bf16_t*)lds;
    LAS bf16_t* Vt = Ks + 272 * LDK;
    int tid = threadIdx.x; asm volatile("" : "+v"(tid));
    const int lane = tid & 63, w = tid >> 6, fr = lane & 15, fq = lane >> 4;
    const float L2E = 1.4426950408889634f;
    unsigned zu = 0u; asm volatile("" : "+v"(zu));
    if (__builtin_amdgcn_readfirstlane(tid) >= 256) __builtin_amdgcn_s_setprio(1);
    u32x4 kreg[4], vreg[4];
#define AT_LOAD(un) do { const int nb_ = (un) & 31, g_ = ((un) >> 5) & 3, b_ = (un) >> 7, seq0_ = b_ * SEQ, blk0_ = nb_ * 128; \
        _Pragma("unroll") for (int pass = 0; pass < 4; ++pass) { const int kj = pass * 64 + (tid >> 3), seg = tid & 7, pos = blk0_ - 128 + kj; \
            kreg[pass] = (u32x4){zu, zu, zu, zu}; if (pos >= 0) kreg[pass] = *(const u32x4*)(QK + (size_t)(seq0_ + pos) * QKD + 1024 + g_ * 64 + seg * 8); } \
        _Pragma("unroll") for (int pass = 0; pass < 4; ++pass) { const int d = pass * 16 + (tid >> 5), seg = tid & 31, pos = blk0_ - 128 + seg * 8; \
            vreg[pass] = (u32x4){zu, zu, zu, zu}; if (pos >= 0) vreg[pass] = *(const u32x4*)(VT + (size_t)(g_ * 64 + d) * MTOK + seq0_ + pos); } } while (0)
    if (bid < BATCH * 4 * 32) AT_LOAD(bid);
    for (int unit = bid; unit < BATCH * 4 * 32; unit += G) {
        const int nb = unit & 31, g = (unit >> 5) & 3, b = unit >> 7;
        const int seq0 = b * SEQ, blk0 = nb * 128;
#pragma unroll
        for (int pass = 0; pass < 4; ++pass) *(LAS u32x4*)(Ks + (pass * 64 + (tid >> 3)) * LDK + (tid & 7) * 8) = kreg[pass];
        if (tid < 128) *(LAS u32x4*)(Ks + (256 + (tid >> 3)) * LDK + (tid & 7) * 8) = (u32x4){zu, zu, zu, zu};
#pragma unroll
        for (int pass = 0; pass < 4; ++pass) *(LAS u32x4*)(Vt + (pass * 16 + (tid >> 5)) * LDV + (tid & 31) * 8) = vreg[pass];
        if (tid < 128) *(LAS u32x4*)(Vt + (tid >> 1) * LDV + 256 + (tid & 1) * 8) = (u32x4){zu, zu, zu, zu};
        const int r = w >> 1, half = w & 1, h = g * 4 + r;
        const bf16_t* qbase = QK + (size_t)(seq0 + blk0 + 64 * half + fr) * QKD + h * 64 + 8 * fq;
        bf16x8 qn[2];
#pragma unroll
        for (int kk = 0; kk < 2; ++kk) qn[kk] = *(const bf16x8*)(qbase + 32 * kk);
        if (unit + G < BATCH * 4 * 32) AT_LOAD(unit + G);
        __syncthreads();
        const float slope2 = __builtin_amdgcn_exp2f(-0.5f * (float)(h + 1)) * L2E, sink2 = sinks[h] * L2E;
        const float c2 = 0.125f * L2E;
#pragma unroll 1
        for (int qt = 0; qt < 4; ++qt) {
            const int j0 = 4 * half + qt, q0 = 16 * j0;
            const size_t tokq = (size_t)(seq0 + blk0 + q0 + fr);
            bf16x8 qf[2]; qf[0] = qn[0]; qf[1] = qn[1];
            if (qt < 3) {
#pragma unroll
                for (int kk = 0; kk < 2; ++kk) qn[kk] = *(const bf16x8*)(qbase + (size_t)(16 * (qt + 1)) * QKD + 32 * kk);
            }
            f32x4 S[10];
#pragma unroll
            for (int jj = 0; jj < 9; ++jj) {
                S[jj] = (f32x4){0.f, 0.f, 0.f, 0.f};
#pragma unroll
                for (int kk = 0; kk < 2; ++kk) { const bf16x8 kf = *(const LAS bf16x8*)(Ks + (16 * (j0 + jj) + fr) * LDK + 32 * kk + 8 * fq);
                    S[jj] = __builtin_amdgcn_mfma_f32_16x16x32_bf16(kf, qf[kk], S[jj], 0, 0, 0); }
            }
            float mx = sink2;
#pragma unroll
            for (int jj = 0; jj < 9; ++jj)
#pragma unroll
                for (int i = 0; i < 4; ++i) {
                    const int kjr = 16 * jj + 4 * fq + i;
                    const int dist = fr + 128 - kjr;
                    const bool valid = (dist >= 0) && (dist < 128) && (blk0 - 128 + q0 + kjr >= 0);
                    const float sv = valid ? (S[jj][i] * c2 - slope2 * (float)dist) : -INFINITY;
                    S[jj][i] = sv; mx = fmaxf(mx, sv);
                }
            mx = fmaxf(mx, __shfl_xor(mx, 16)); mx = fmaxf(mx, __shfl_xor(mx, 32));
            float sum = 0.f;
#pragma unroll
            for (int jj = 0; jj < 9; ++jj)
#pragma unroll
                for (int i = 0; i < 4; ++i) { const float p = __builtin_amdgcn_exp2f(S[jj][i] - mx); S[jj][i] = p; sum += p; }
            S[9] = (f32x4){0.f, 0.f, 0.f, 0.f};
            sum += __shfl_xor(sum, 16); sum += __shfl_xor(sum, 32);
            const float inv = 1.0f / (sum + __builtin_amdgcn_exp2f(sink2 - mx));
            f32x4 oa[4];
#pragma unroll
            for (int dt = 0; dt < 4; ++dt) oa[dt] = (f32x4){0.f, 0.f, 0.f, 0.f};
#pragma unroll
            for (int ks = 0; ks < 5; ++ks) {
                u32x4 pw; pw.x = cvt_pk_bf16(S[2 * ks][0], S[2 * ks][1]); pw.y = cvt_pk_bf16(S[2 * ks][2], S[2 * ks][3]);
                pw.z = cvt_pk_bf16(S[2 * ks + 1][0], S[2 * ks + 1][1]); pw.w = cvt_pk_bf16(S[2 * ks + 1][2], S[2 * ks + 1][3]);
                const bf16x8 pf = __builtin_bit_cast(bf16x8, pw);
#pragma unroll
                for (int dt = 0; dt < 4; ++dt) {
                    const LAS bf16_t* vp = Vt + (16 * dt + fr) * LDV + 16 * (j0 + 2 * ks) + 4 * fq;
                    const u32x2 lo = *(const LAS u32x2*)vp, hi = *(const LAS u32x2*)(vp + 16);
                    const u32x4 vv = (u32x4){lo.x, lo.y, hi.x, hi.y};
                    oa[dt] = __builtin_amdgcn_mfma_f32_16x16x32_bf16(__builtin_bit_cast(bf16x8, vv), pf, oa[dt], 0, 0, 0);
                }
            }
            bf16_t* op = O + tokq * DM + h * 64 + 16 * (fq & 1) + 8 * (fq >> 1);
#pragma unroll
            for (int dt = 0; dt < 4; dt += 2) {
                const unsigned ax = cvt_pk_bf16(oa[dt][0] * inv, oa[dt][1] * inv), ay = cvt_pk_bf16(oa[dt][2] * inv, oa[dt][3] * inv);
                const unsigned bx = cvt_pk_bf16(oa[dt + 1][0] * inv, oa[dt + 1][1] * inv), by = cvt_pk_bf16(oa[dt + 1][2] * inv, oa[dt + 1][3] * inv);
                const auto s0 = __builtin_amdgcn_permlane16_swap(ax, bx, false, false), s1 = __builtin_amdgcn_permlane16_swap(ay, by, false, false);
                *(u32x4*)(op + 16 * dt) = (u32x4){s0[0], s1[0], s0[1], s1[1]};
            }
        }
        __syncthreads();
    }
    __builtin_amdgcn_s_setprio(0);
#undef AT_LOAD
}

__device__ __forceinline__ void spatial_phase(LAS unsigned char* lds, const bf16_t* VT, bf16_t* U, const bf16_t* Wsb, const float* psum, const float* psq,
                                              const float* lng, const float* lnb, const float* bs, int G, int bid) {
    constexpr int LDA = 136, NU = (MTOK / CHK) * NGRP;
    LAS bf16_t* As = (LAS bf16_t*)lds;
    LAS bf16_t* Bs = As + 2 * 128 * LDA;
    LAS float* tbl0 = (LAS float*)(Bs + 128 * LDA);
    LAS float* st = tbl0 + 512;
    LAS float* red = st + 256;
    int tid = threadIdx.x; asm volatile("" : "+v"(tid));
    const int lane = tid & 63, w = tid >> 6, fr = lane & 15, fq = lane >> 4;
    const int srow = tid >> 4, sseg = tid & 15, tt = tid & 127, part = tid >> 7;
    if (__builtin_amdgcn_readfirstlane(tid) >= 256) __builtin_amdgcn_s_setprio(1);
    int unit = bid * 8;
    if (unit >= NU) return;
    float sp[12], lgn[4], lbn[4], bsn = 0.f; u32x4 wraw[4], R[4], uvn[4], uvc[4];
#define SP_LOAD_SP(un) do { const int tok0_ = ((un) >> 3) * CHK; if (((un) & 7) == 0) { _Pragma("unroll") for (int k = 0; k < 6; ++k) { sp[k] = psum[(size_t)(part * 6 + k) * MTOK + tok0_ + tt]; sp[6 + k] = psq[(size_t)(part * 6 + k) * MTOK + tok0_ + tt]; } } \
        if (tid < 128) bsn = bs[((un) & 7) * CHK + tid]; } while (0)
#define SP_LOAD_W(un) do { const int g_ = (un) & 7; _Pragma("unroll") for (int p = 0; p < 4; ++p) wraw[p] = *(const u32x4*)(Wsb + (size_t)(g_ * CHK + p * 32 + srow) * CHK + sseg * 8); } while (0)
#define SP_LOAD_R(un, db_) do { const int g_ = (un) & 7, tok0_ = ((un) >> 3) * CHK; _Pragma("unroll") for (int p = 0; p < 4; ++p) { const int f_ = g_ * GD + (db_) * 128 + p * 32 + srow; \
        R[p] = *(const u32x4*)(VT + (size_t)f_ * MTOK + tok0_ + sseg * 8); lgn[p] = lng[f_]; lbn[p] = lnb[f_]; } } while (0)
#define SP_LOAD_UV(un, db_) do { const int g_ = (un) & 7, tok0_ = ((un) >> 3) * CHK; _Pragma("unroll") for (int q = 0; q < 4; ++q) uvn[q] = *(const u32x4*)(U + (size_t)(tok0_ + 16 * (2 * q + (fq & 1)) + fr) * SH + g_ * GD + (db_) * 128 + 16 * w + 8 * (fq >> 1)); } while (0)
#define SP_WRITE_A(buf) do { _Pragma("unroll") for (int p = 0; p < 4; ++p) { float o_[8]; const float lg_ = lgn[p], lb_ = lbn[p]; \
        _Pragma("unroll") for (int e = 0; e < 4; ++e) { const unsigned wv_ = R[p][e]; const f32x4 m_ = *(const LAS f32x4*)(st + 2 * (sseg * 8 + 2 * e)); \
            o_[2 * e] = (bf_lo(wv_) - m_[0]) * m_[1] * lg_ + lb_; o_[2 * e + 1] = (bf_hi(wv_) - m_[2]) * m_[3] * lg_ + lb_; } \
        u32x4 pk_; pk_.x = cvt_pk_bf16(o_[0], o_[1]); pk_.y = cvt_pk_bf16(o_[2], o_[3]); pk_.z = cvt_pk_bf16(o_[4], o_[5]); pk_.w = cvt_pk_bf16(o_[6], o_[7]); \
        *(LAS u32x4*)(As + (buf) * 128 * LDA + (p * 32 + srow) * LDA + sseg * 8) = pk_; } } while (0)
    SP_LOAD_SP(unit); SP_LOAD_W(unit); SP_LOAD_R(unit, 0); SP_LOAD_UV(unit, 0);
    for (;;) {
        const int g = unit & 7, tok0 = (unit >> 3) * CHK;
        LAS float* tbl = tbl0 + (unit & 1) * 128;
        const int nu = ((unit & 7) < 7) ? unit + 1 : unit + 8 * G - 7;
        const bool has_next = nu < NU;
        if (g == 0) {
            { const float s6 = ((sp[0] + sp[1]) + (sp[2] + sp[3])) + (sp[4] + sp[5]), q6 = ((sp[6] + sp[7]) + (sp[8] + sp[9])) + (sp[10] + sp[11]);
              *(LAS f32x2*)(red + (part * 128 + tt) * 2) = (f32x2){s6, q6}; }
            __syncthreads();
            if (tid < 128) {
                const f32x2 a0 = *(const LAS f32x2*)(red + tid * 2), a1 = *(const LAS f32x2*)(red + (128 + tid) * 2), a2 = *(const LAS f32x2*)(red + (256 + tid) * 2), a3 = *(const LAS f32x2*)(red + (384 + tid) * 2);
                const float mean = ((a0.x + a1.x) + (a2.x + a3.x)) * (1.f / SH), var = fmaxf(((a0.y + a1.y) + (a2.y + a3.y)) * (1.f / SH) - mean * mean, 0.f);
                *(LAS f32x2*)(st + 2 * tid) = (f32x2){mean, __builtin_amdgcn_rsqf(var + EPS)};
            }
        }
        if (tid < 128) tbl[tid] = bsn;
        __syncthreads();
#pragma unroll
        for (int p = 0; p < 4; ++p) *(LAS u32x4*)(Bs + (p * 32 + srow) * LDA + sseg * 8) = wraw[p];
        SP_WRITE_A(0);
#pragma unroll
        for (int q = 0; q < 4; ++q) uvc[q] = uvn[q];
        __syncthreads();
#pragma unroll
        for (int db = 0; db < 3; ++db) {
            const LAS bf16_t* Ab = As + (db & 1) * 128 * LDA;
            if (db < 2) { SP_LOAD_R(unit, db + 1); SP_LOAD_UV(unit, db + 1); }
            else if (has_next) { SP_LOAD_SP(nu); SP_LOAD_W(nu); SP_LOAD_R(nu, 0); SP_LOAD_UV(nu, 0); }
            const int fcol = g * GD + db * 128 + 16 * w + 4 * fq;
            f32x4 acc[8];
#pragma unroll
            for (int n = 0; n < 8; ++n) acc[n] = (f32x4){0.f, 0.f, 0.f, 0.f};
#pragma unroll
            for (int kk = 0; kk < 4; ++kk) {
                const bf16x8 a = *(const LAS bf16x8*)(Ab + (16 * w + fr) * LDA + 32 * kk + 8 * fq);
#pragma unroll
                for (int n = 0; n < 8; ++n) { const bf16x8 bb = *(const LAS bf16x8*)(Bs + (16 * n + fr) * LDA + 32 * kk + 8 * fq);
                    acc[n] = __builtin_amdgcn_mfma_f32_16x16x32_bf16(a, bb, acc[n], 0, 0, 0); }
            }
#pragma unroll
            for (int q = 0; q < 4; ++q) {
                const float bsA = tbl[32 * q + fr], bsB = tbl[32 * q + 16 + fr];
                const u32x4 L = uvc[q];
                const auto u0 = __builtin_amdgcn_permlane16_swap(L.x, L.z, false, false), u1 = __builtin_amdgcn_permlane16_swap(L.y, L.w, false, false);
                const unsigned pAx = cvt_pk_bf16((acc[2 * q][0] + bsA) * bf_lo(u0[0]), (acc[2 * q][1] + bsA) * bf_hi(u0[0])), pAy = cvt_pk_bf16((acc[2 * q][2] + bsA) * bf_lo(u1[0]), (acc[2 * q][3] + bsA) * bf_hi(u1[0]));
                const unsigned pBx = cvt_pk_bf16((acc[2 * q + 1][0] + bsB) * bf_lo(u0[1]), (acc[2 * q + 1][1] + bsB) * bf_hi(u0[1])), pBy = cvt_pk_bf16((acc[2 * q + 1][2] + bsB) * bf_lo(u1[1]), (acc[2 * q + 1][3] + bsB) * bf_hi(u1[1]));
                const auto s0 = __builtin_amdgcn_permlane16_swap(pAx, pBx, false, false), s1 = __builtin_amdgcn_permlane16_swap(pAy, pBy, false, false);
                *(u32x4*)(U + (size_t)(tok0 + 16 * (2 * q + (fq & 1)) + fr) * SH + g * GD + db * 128 + 16 * w + 8 * (fq >> 1)) = (u32x4){s0[0], s1[0], s0[1], s1[1]};
            }
            if (db < 2) {
                SP_WRITE_A((db + 1) & 1);
#pragma unroll
                for (int q = 0; q < 4; ++q) uvc[q] = uvn[q];
                __syncthreads();
            }
        }
        if (!has_next) break;
        unit = nu;
    }
    __builtin_amdgcn_s_setprio(0);
#undef SP_LOAD_SP
#undef SP_LOAD_W
#undef SP_LOAD_R
#undef SP_LOAD_UV
#undef SP_WRITE_A
}

#define XB_TMO      128
#define XB_XCNT(j)  (256  + 64 * (j))
#define XB_XSUB(j)  (1280 + 64 * (j))
#define XB_XGEN(j)  (2304 + 64 * (j))
#define XB_TOP      3328
#define XB_TOPGEN   3392
#define XCD_BAR_WORDS 3456
#define XB_SPIN_CAP (1u << 22)
__device__ __forceinline__ unsigned xb_ld(unsigned* p)              { return __hip_atomic_load(p, __ATOMIC_RELAXED, __HIP_MEMORY_SCOPE_AGENT); }
__device__ __forceinline__ unsigned xb_add(unsigned* p, unsigned v) { return __hip_atomic_fetch_add(p, v, __ATOMIC_RELAXED, __HIP_MEMORY_SCOPE_AGENT); }
__device__ __forceinline__ unsigned xb_xcc_id() { return (unsigned)__builtin_amdgcn_s_getreg((3 << 11) | 20) & 0xFu; }
#define XB_SPIN(cond, bar) do { unsigned _sp = 0; while (cond) { __builtin_amdgcn_s_sleep(1); \
    if ((++_sp & 255u) == 0u) { if (xb_ld(&(bar)[XB_TMO])) break; if (_sp > XB_SPIN_CAP) { atomicAdd(&(bar)[XB_TMO], 1u); break; } } } } while (0)
struct XcdBarrier { unsigned* bar; unsigned x; volatile LAS unsigned* st; };
__device__ __forceinline__ XcdBarrier xcd_barrier_post(unsigned* bar, volatile LAS unsigned* st) {
    XcdBarrier b; b.bar = bar; b.x = xb_xcc_id(); b.st = st;
    if (threadIdx.x == 0) (void)xb_add(&bar[XB_XCNT(b.x)], 1u);
    return b;
}
__device__ __forceinline__ void xcd_barrier_complete(unsigned* bar, unsigned x, unsigned& nloc, unsigned& nx) {
    const unsigned G = gridDim.x * gridDim.y * gridDim.z;
    unsigned sum, cnt, mine, sp = 0u;
    for (;;) {
        sum = 0u; cnt = 0u; mine = 0u;
#pragma unroll
        for (unsigned j = 0; j < 16; ++j) { const unsigned c = xb_ld(&bar[XB_XCNT(j)]); sum += c; cnt += (c > 0u) ? 1u : 0u; mine = (j == x) ? c : mine; }
        if (sum == G) break;
        __builtin_amdgcn_s_sleep(1);
        if ((++sp & 255u) == 0u) { if (xb_ld(&bar[XB_TMO])) break; if (sp > XB_SPIN_CAP) { atomicAdd(&bar[XB_TMO], 1u); break; } }
    }
    nloc = mine > 0u ? mine : 1u; nx = cnt > 0u ? cnt : 1u;
}
__device__ __forceinline__ void xcd_barrier(const XcdBarrier& b) {
    asm volatile("s_waitcnt vmcnt(0)" ::: "memory");
    __syncthreads();
    if (threadIdx.x == 0) {
        unsigned* bar = b.bar;
        __builtin_amdgcn_s_waitcnt(0);
        unsigned nloc = b.st[0], nx = b.st[1];
        if (nloc == 0u) { xcd_barrier_complete(bar, b.x, nloc, nx); b.st[0] = nloc; b.st[1] = nx; }
        const unsigned old = xb_add(&bar[XB_XSUB(b.x)], 1u);
        const unsigned gen = old / nloc;
        if (old + 1u == (gen + 1u) * nloc) {
            __builtin_amdgcn_fence(__ATOMIC_RELEASE, "agent");
            asm volatile("s_waitcnt vmcnt(0)" ::: "memory");
            const unsigned og = xb_add(&bar[XB_TOP], 1u);
            const unsigned tg = og / nx;
            if (og + 1u == (tg + 1u) * nx) xb_add(&bar[XB_TOPGEN], 1u);
            else XB_SPIN(xb_ld(&bar[XB_TOPGEN]) == tg, bar);
            __builtin_amdgcn_fence(__ATOMIC_ACQUIRE, "agent");
            xb_add(&bar[XB_XGEN(b.x)], 1u);
            asm volatile("s_waitcnt vmcnt(0)" ::: "memory");
        } else {
            XB_SPIN(xb_ld(&bar[XB_XGEN(b.x)]) == gen, bar);
            __builtin_amdgcn_fence(__ATOMIC_ACQUIRE, "agent");
            asm volatile("s_waitcnt vmcnt(0)" ::: "memory");
        }
    }
    __syncthreads();
}

constexpr int LDS_RING = 131072, LDS_X = LDS_RING, LDS_BYTES = LDS_RING + 16384;

#define PHASE_IDS() int tid_ = threadIdx.x; asm volatile("" : "+v"(tid_)); const int lane = tid_ & 63, wave = __builtin_amdgcn_readfirstlane(tid_ >> 6); \
    const int gw = bid * NWAVES + wave, NGW = G * NWAVES; LAS float* scr = (LAS float*)(lds + wave * 16384)

__global__ void __launch_bounds__(NTHREADS, 2) fwd_megakernel(Params Pk) {
    extern __shared__ __attribute__((aligned(16))) unsigned char lds_raw[];
    cg::grid_group grid = cg::this_grid();
    LAS unsigned char* lds = (LAS unsigned char*)lds_raw;
    const int G = gridDim.x, bid = blockIdx.x;
#define P (*(const Params*)__builtin_amdgcn_kernarg_segment_ptr())
    volatile LAS unsigned* MISC = (volatile LAS unsigned*)(lds + LDS_X + 4096);
    if (threadIdx.x < 2) MISC[threadIdx.x] = 0u;
    __syncthreads();
    (void)xcd_barrier_post((unsigned*)P.ws, MISC);
#define GRID_BAR() do { XcdBarrier xb_; xb_.bar = (unsigned*)P.ws; xb_.x = xb_xcc_id(); xb_.st = (volatile LAS unsigned*)(lds + LDS_X + 4096); xcd_barrier(xb_); } while (0)
    {
        PHASE_IDS();
        convert_mixer(P, 0, scr, gw, NGW, lane);
        xb0_phase(P.in[0], (bf16_t*)(P.ws + WS_XN), (float*)(P.ws + WS_ROWSS), gw, NGW, lane);
    }
    grid.sync();

    for (int hl = 0; hl < 2 * DEPTH; ++hl) {
        const int L = hl >> 1, j = L >> 1;
        const bool attn = (L & 1) == 0;
        if ((hl & 1) == 0) {
            {
                PHASE_IDS();
                convert_ffn(P, L, scr, gw, NGW, lane);
                __syncthreads();
            }
            {
                unsigned char* ws = P.ws;
                const bf16_t* wv = (const bf16_t*)(ws + WS_WMIX + WM_A) + (size_t)(attn ? QKD : SH) * DM;
                pg8::Gemm g1{(const bf16_t*)(ws + WS_XN), (const bf16_t*)(ws + WS_WMIX + WM_A), DM, wv, (const bf16_t*)(ws + WS_XN)};
                pg8::Order S; S.init(MTOK / 256, attn ? QKD / 256 : SH / 256, G, bid, 0, attn ? KVD / 256 : SH / 256, MTOK / 256);
                EpiG1 E{attn ? 1 : 0, j};
                pg8::gemm_phase(lds, g1, S, E);
            }
            GRID_BAR();
            if (attn) {
                unsigned char* ws = P.ws;
                attn_phase(lds, (const bf16_t*)(ws + WS_BIG), (const bf16_t*)(ws + WS_BIG + 80 * MiB), (bf16_t*)(ws + WS_BIG + 96 * MiB), P.in[3] + j * NH, G, bid);
            } else {
                unsigned char* ws = P.ws;
                spatial_phase(lds, (const bf16_t*)(ws + WS_BIG + 192 * MiB), (bf16_t*)(ws + WS_BIG), (const bf16_t*)(ws + WS_WMIX + WM_S), (const float*)(ws + WS_PSUM), (const float*)(ws + WS_PSQ),
                              P.in[7] + (size_t)j * SH, P.in[8] + (size_t)j * SH, P.in[10] + (size_t)j * NGRP * CHK, G, bid);
            }
            GRID_BAR();
        } else {
            if (L + 1 < DEPTH) {
                PHASE_IDS();
                convert_mixer(P, L + 1, scr, gw, NGW, lane);
                __syncthreads();
            }
            unsigned char* ws = P.ws;
            pg8::Gemm g1{(const bf16_t*)(ws + WS_XN), (const bf16_t*)(ws + WS_WFFN + WF_A), DM, nullptr, nullptr};
            pg8::Order S; S.init(MTOK / 256, 2 * DFF / 256, G, bid, 0);
            EpiConv E{L, (LAS float*)(lds + LDS_X)};
            pg8::gemm_phase(lds, g1, S, E);
            GRID_BAR();
        }
        {
            unsigned char* ws = P.ws;
            pg8::Gemm gy;
            if ((hl & 1) == 0) {
                if (attn) gy = pg8::Gemm{(const bf16_t*)(ws + WS_BIG + 96 * MiB), (const bf16_t*)(ws + WS_WMIX + WM_B), DM, nullptr, nullptr};
                else gy = pg8::Gemm{(const bf16_t*)(ws + WS_BIG), (const bf16_t*)(ws + WS_WMIX + WM_B), SH, nullptr, nullptr};
            } else gy = pg8::Gemm{(const bf16_t*)(ws + WS_BIG), (const bf16_t*)(ws + WS_WFFN + WF_B), DFF, nullptr, nullptr};
            pg8::Order S; S.init(MTOK / 256, DM / 256, G, bid, 0);
            if (hl & 1) {
                int tid_ = threadIdx.x; asm volatile("" : "+v"(tid_));
                pg8::Unit fu;
                for (int i = 0; S.next(i, fu); ++i) ffn_fixup(fu.pm, L, tid_);
                asm volatile("s_waitcnt vmcnt(0)" ::: "memory"); __syncthreads();
            }
            EpiResid E{hl, (LAS float*)(lds + LDS_X + 8192), (LAS float*)(lds + LDS_X + 12288)};
            pg8::gemm_phase(lds, gy, S, E);
        }
        if (hl + 1 < 2 * DEPTH) GRID_BAR();
    }
#undef P
#undef GRID_BAR
}

extern "C" void kernel_launch(void* const* d_in, const int* in_sizes, int n_in, void* d_out, int out_size, void* d_ws, size_t ws_size, hipStream_t stream) {
    static int grid = 0;
    if (grid == 0) {
        if (n_in != 20 || in_sizes[0] != MTOK * DM || out_size != MTOK * DM || ws_size < WS_END) {
            fprintf(stderr, "kernel_launch: unexpected shapes (n_in %d, in0 %d, out %d, ws %zu, need %zu); nothing launched\n", n_in, n_in > 0 ? in_sizes[0] : -1, out_size, ws_size, (size_t)WS_END);
            grid = -1; return; }
        int dev = 0, cus = 0, per_cu = 0;
        hipGetDevice(&dev);
        hipDeviceGetAttribute(&cus, hipDeviceAttributeMultiprocessorCount, dev);
        hipFuncSetAttribute((const void*)fwd_megakernel, hipFuncAttributeMaxDynamicSharedMemorySize, LDS_BYTES);
        hipOccupancyMaxActiveBlocksPerMultiprocessor(&per_cu, (const void*)fwd_megakernel, NTHREADS, LDS_BYTES);
        if (per_cu < 1) per_cu = 1;
        (void)hipGetLastError();
        grid = cus;
    }
    if (grid < 0) return;
    if (hipMemsetAsync(d_ws, 0, 131072, stream) != hipSuccess) { fprintf(stderr, "kernel_launch: memset failed\n"); return; }
    if (hipMemsetAsync((char*)d_ws + WS_SLOT, 0, 1u << 20, stream) != hipSuccess) { fprintf(stderr, "kernel_launch: memset failed\n"); return; }
    Params p{};
    for (int i = 0; i < 20; ++i) p.in[i] = (const float*)d_in[i];
    p.out = (float*)d_out; p.ws = (unsigned char*)d_ws;
    void* args[] = {&p};
    hipError_t e = hipLaunchCooperativeKernel((const void*)fwd_megakernel, dim3(grid), dim3(NTHREADS), args, LDS_BYTES, stream);
    if (e != hipSuccess) fprintf(stderr, "cooperative launch failed: %s (grid %d)\n", hipGetErrorString(e), grid);
}
```
